# Optimizing an MI355X kernel written in HIP

```python
import math
import jax, jax.numpy as jnp
from jax import lax
import numpy as np

D_MODEL = 1024
BATCH = 2
SEQ = 16384
DEPTH = 2

GRID_W = 64
HEAD_DIM = 64
QB = 128
N_BRANCH = 4
BRANCH_W = 256
A_HEADS = 4
A_KV_HEADS = 2
B_HEADS = 4
NA_ROWS = 8
NA_COLS = 16
C_HEADS = 4
C_KV_HEADS = 2
WINDOW = 128
D_HEADS = 4
MLA_Q_RANK = 192
MLA_KV_RANK = 128
MLA_NOPE = 64
MLA_ROPE = 32
MLA_V = 64
D_FF = 4 * D_MODEL
ROPE_THETA = 10000.0
EPS = 1e-6

IN_SPLITS = (
    A_HEADS * HEAD_DIM, A_KV_HEADS * HEAD_DIM, A_KV_HEADS * HEAD_DIM,
    B_HEADS * HEAD_DIM, B_HEADS * HEAD_DIM, B_HEADS * HEAD_DIM,
    C_HEADS * HEAD_DIM, C_KV_HEADS * HEAD_DIM, C_KV_HEADS * HEAD_DIM,
    MLA_Q_RANK, MLA_KV_RANK, MLA_ROPE,
)
IN_W = sum(IN_SPLITS)

kernel_name = "hybrid_gated_parallel_encoder"


def rms_norm(x, g):
    x32 = x.astype(jnp.float32)
    y = x32 * lax.rsqrt(jnp.mean(x32 * x32, axis=-1, keepdims=True) + EPS)
    return y.astype(x.dtype) * g


def rope(x, pos):
    d = x.shape[-1]
    half = d // 2
    inv = jnp.power(ROPE_THETA, -jnp.arange(half, dtype=jnp.float32) / half)
    ang = pos.astype(jnp.float32)[:, None] * inv
    ang = ang.reshape((ang.shape[0],) + (1,) * (x.ndim - 3) + (half,))
    c, s = jnp.cos(ang).astype(x.dtype), jnp.sin(ang).astype(x.dtype)
    x1, x2 = x[..., :half], x[..., half:]
    return jnp.concatenate([x1 * c - x2 * s, x2 * c + x1 * s], axis=-1)


def axial_rope(x, row, col):
    half = x.shape[-1] // 2
    return jnp.concatenate([rope(x[..., :half], row), rope(x[..., half:], col)], axis=-1)


def global_attention(q, k, v, scale):
    B, S, Hk, G, dq = q.shape
    nb = S // QB
    qb = q.reshape(B, nb, QB, Hk, G, dq).transpose(1, 0, 2, 3, 4, 5)

    def one(qblk):
        s = jnp.einsum('bqkgd,bskd->bkgqs', qblk, k).astype(jnp.float32) * scale
        p = jax.nn.softmax(s, axis=-1).astype(v.dtype)
        return jnp.einsum('bkgqs,bskd->bqkgd', p, v)

    o = lax.map(one, qb)
    return o.transpose(1, 0, 2, 3, 4, 5).reshape(B, S, Hk * G * v.shape[-1])


def neighbourhood_attention(q, k, v, rel_bias):
    B, S, H, hd = q.shape
    rows = S // GRID_W
    wr, wc = min(NA_ROWS, rows), NA_COLS
    nk = wr * wc
    t = jnp.arange(S, dtype=jnp.int32)
    r, c = t // GRID_W, t % GRID_W
    rs = jnp.clip(r - wr // 2, 0, rows - wr)
    cs = jnp.clip(c - wc // 2, 0, GRID_W - wc)
    kr = rs[:, None] + jnp.arange(wr, dtype=jnp.int32)
    kc = cs[:, None] + jnp.arange(wc, dtype=jnp.int32)
    idx = (kr[:, :, None] * GRID_W + kc[:, None, :]).reshape(S, nk)
    dr = kr - r[:, None] + (NA_ROWS - 1)
    dc = kc - c[:, None] + (NA_COLS - 1)
    bidx = (dr[:, :, None] * (2 * NA_COLS - 1) + dc[:, None, :]).reshape(S, nk)
    table = rel_bias.reshape(H, -1).astype(jnp.float32)
    nb = S // QB
    qb = q.reshape(B, nb, QB, H, hd).transpose(1, 0, 2, 3, 4)
    scale = hd ** -0.5

    def one(args):
        qblk, ib, bb = args
        kg, vg = k[:, ib], v[:, ib]
        s = jnp.einsum('bqhd,bqkhd->bhqk', qblk, kg).astype(jnp.float32) * scale
        s = s + table[:, bb][None]
        p = jax.nn.softmax(s, axis=-1).astype(v.dtype)
        return jnp.einsum('bhqk,bqkhd->bqhd', p, vg)

    o = lax.map(one, (qb, idx.reshape(nb, QB, nk), bidx.reshape(nb, QB, nk)))
    return o.transpose(1, 0, 2, 3, 4).reshape(B, S, H * hd)


def window_sink_attention(q, k, v, sink):
    B, S, Hk, G, hd = q.shape
    nb = S // QB
    qb = q.reshape(B, nb, QB, Hk, G, hd)

    def bands(a):
        ap = jnp.pad(a, ((0, 0), (QB, QB), (0, 0), (0, 0))).reshape(B, nb + 2, QB, Hk, a.shape[-1])
        return jnp.concatenate([ap[:, :-2], ap[:, 1:-1], ap[:, 2:]], axis=2)

    kb, vb = bands(k), bands(v)
    s = jnp.einsum('bnqkgd,bnskd->bnkgqs', qb, kb).astype(jnp.float32) * (hd ** -0.5)
    i = jnp.arange(QB, dtype=jnp.int32)
    l = jnp.arange(3 * QB, dtype=jnp.int32)
    diff = i[:, None] - l[None, :] + QB
    kpos = (jnp.arange(nb, dtype=jnp.int32)[:, None] - 1) * QB + l[None, :]
    mask = (jnp.abs(diff) <= WINDOW)[None] & ((kpos >= 0) & (kpos < S))[:, None, :]
    slopes = jnp.exp2(-8.0 * jnp.arange(1, Hk * G + 1, dtype=jnp.float32) / (Hk * G))
    alibi = -slopes.reshape(Hk, G)[:, :, None, None] * jnp.abs(diff).astype(jnp.float32)
    s = jnp.where(mask[None, :, None, None], s + alibi, -jnp.inf)
    sk = jnp.broadcast_to(sink.reshape(Hk, G)[:, :, None, None].astype(jnp.float32), s.shape[:-1] + (1,))
    p = jax.nn.softmax(jnp.concatenate([s, sk], axis=-1), axis=-1)[..., :-1].astype(v.dtype)
    o = jnp.einsum('bnkgqs,bnskd->bnqkgd', p, vb)
    return o.reshape(B, S, Hk * G * hd)


def setup_inputs(seed: int = 0) -> dict:
    key = jax.random.key(seed)
    ks = jax.random.split(key, 24)

    def nrm(k, shape, scale):
        return jax.random.normal(k, shape, jnp.float32) * scale

    D = D_MODEL
    return {
        "x": nrm(ks[0], (BATCH, SEQ, D), 1.0),
        "norm1_g": 1.0 + nrm(ks[1], (DEPTH, D), 0.05),
        "w_in": nrm(ks[2], (DEPTH, D, IN_W), D ** -0.5),
        "w_gate": nrm(ks[3], (DEPTH, D, N_BRANCH * D), D ** -0.5),
        "b_gate": nrm(ks[4], (DEPTH, N_BRANCH * D), 0.1),
        "a_q_norm_g": 1.0 + nrm(ks[5], (DEPTH, HEAD_DIM), 0.05),
        "a_k_norm_g": 1.0 + nrm(ks[6], (DEPTH, HEAD_DIM), 0.05),
        "b_rel_bias": nrm(ks[7], (DEPTH, B_HEADS, 2 * NA_ROWS - 1, 2 * NA_COLS - 1), 0.5),
        "c_sink": nrm(ks[8], (DEPTH, C_HEADS), 0.5),
        "d_q_norm_g": 1.0 + nrm(ks[9], (DEPTH, MLA_Q_RANK), 0.05),
        "d_kv_norm_g": 1.0 + nrm(ks[10], (DEPTH, MLA_KV_RANK), 0.05),
        "d_w_uq": nrm(ks[11], (DEPTH, MLA_Q_RANK, D_HEADS * (MLA_NOPE + MLA_ROPE)), MLA_Q_RANK ** -0.5),
        "d_w_ukv": nrm(ks[12], (DEPTH, MLA_KV_RANK, D_HEADS * (MLA_NOPE + MLA_V)), MLA_KV_RANK ** -0.5),
        "w_branch": nrm(ks[13], (DEPTH, N_BRANCH, BRANCH_W, D), BRANCH_W ** -0.5),
        "w_o": nrm(ks[14], (DEPTH, D, D), D ** -0.5),
        "norm2_g": 1.0 + nrm(ks[15], (DEPTH, D), 0.05),
        "w_ff1": nrm(ks[16], (DEPTH, D, D_FF), D ** -0.5),
        "w_ff2": nrm(ks[17], (DEPTH, D_FF, D), D_FF ** -0.5),
        "final_g": 1.0 + nrm(ks[18], (D,), 0.05),
    }


def reference(x, norm1_g, w_in, w_gate, b_gate, a_q_norm_g, a_k_norm_g, b_rel_bias,
              c_sink, d_q_norm_g, d_kv_norm_g, d_w_uq, d_w_ukv, w_branch, w_o,
              norm2_g, w_ff1, w_ff2, final_g):
    B, S, D = x.shape
    t = jnp.arange(S, dtype=jnp.int32)
    row, col = t // GRID_W, t % GRID_W
    cuts = np.cumsum(IN_SPLITS)[:-1].tolist()
    for l in range(DEPTH):
        h = rms_norm(x, norm1_g[l])
        (aq, ak, av, bq, bk, bv, cq, ck, cv,
         c_q, c_kv, k_rope) = jnp.split(h @ w_in[l], cuts, axis=-1)

        aq = rms_norm(aq.reshape(B, S, A_HEADS, HEAD_DIM), a_q_norm_g[l])
        ak = rms_norm(ak.reshape(B, S, A_KV_HEADS, HEAD_DIM), a_k_norm_g[l])
        aq = axial_rope(aq.reshape(B, S, A_KV_HEADS, A_HEADS // A_KV_HEADS, HEAD_DIM), row, col)
        ak = axial_rope(ak, row, col)
        o_a = global_attention(aq, ak, av.reshape(B, S, A_KV_HEADS, HEAD_DIM), HEAD_DIM ** -0.5)

        o_b = neighbourhood_attention(bq.reshape(B, S, B_HEADS, HEAD_DIM),
                                      bk.reshape(B, S, B_HEADS, HEAD_DIM),
                                      bv.reshape(B, S, B_HEADS, HEAD_DIM), b_rel_bias[l])

        o_c = window_sink_attention(cq.reshape(B, S, C_KV_HEADS, C_HEADS // C_KV_HEADS, HEAD_DIM),
                                    ck.reshape(B, S, C_KV_HEADS, HEAD_DIM),
                                    cv.reshape(B, S, C_KV_HEADS, HEAD_DIM), c_sink[l])

        qd = (rms_norm(c_q, d_q_norm_g[l]) @ d_w_uq[l]).reshape(B, S, D_HEADS, MLA_NOPE + MLA_ROPE)
        q_nope, q_rot = qd[..., :MLA_NOPE], rope(qd[..., MLA_NOPE:], t)
        kvd = (rms_norm(c_kv, d_kv_norm_g[l]) @ d_w_ukv[l]).reshape(B, S, D_HEADS, MLA_NOPE + MLA_V)
        k_nope, vd = kvd[..., :MLA_NOPE], kvd[..., MLA_NOPE:]
        k_rot = jnp.broadcast_to(rope(k_rope[:, :, None, :], t), (B, S, D_HEADS, MLA_ROPE))
        qd = jnp.concatenate([q_nope, q_rot], axis=-1)[:, :, :, None, :]
        kd = jnp.concatenate([k_nope, k_rot], axis=-1)
        o_d = global_attention(qd, kd, vd, (MLA_NOPE + MLA_ROPE) ** -0.5)

        br = jnp.stack([o_a, o_b, o_c, o_d], axis=2)
        y = jnp.einsum('bsnc,ncd->bsnd', br, w_branch[l])
        g = jax.nn.sigmoid(h @ w_gate[l] + b_gate[l]).reshape(B, S, N_BRANCH, D)
        x = x + jnp.sum(g * y, axis=2) @ w_o[l]

        h2 = rms_norm(x, norm2_g[l])
        x = x + jnp.square(jax.nn.relu(h2 @ w_ff1[l])) @ w_ff2[l]
    return rms_norm(x, final_g)
```

```cpp
#include <hip/hip_runtime.h>
#include <hip/hip_cooperative_groups.h>
#include <cstdio>
#include <cstdint>
namespace cg = cooperative_groups;

#ifndef PROBE_DUP
#define PROBE_DUP 0
#endif
#ifndef MK_PER_PHASE
#define MK_PER_PHASE 0
#endif

namespace pg8 {
#define PG8_LAS __attribute__((address_space(3)))
typedef unsigned short bf16_t;
typedef short bf16x8 __attribute__((ext_vector_type(8)));
typedef float f32x4 __attribute__((ext_vector_type(4)));
typedef float f32x2 __attribute__((ext_vector_type(2)));
typedef unsigned u32x4 __attribute__((ext_vector_type(4)));
typedef unsigned u32x2 __attribute__((ext_vector_type(2)));
constexpr int BM = 256, BK = 64, HALF = 128, HTB = HALF * BK * 2, STAGE_BYTES = 8 * HTB, NXCD = 8, WGM = 8;

__host__ __device__ __forceinline__ int lds_byte(int r, int c) { const int st = (r >> 4) * 2 + (c >> 5), rr = r & 15, cc = c & 31, ob = rr * 64 + cc * 2; return st * 1024 + (ob ^ (((ob >> 9) & 1) << 5)); }
__host__ __device__ __forceinline__ void stage_rc(int b, int& R, int& C) { const int st = b / 1024, sb = b % 1024, swz = sb ^ (((sb >> 9) & 1) << 5); R = (st >> 1) * 16 + swz / 64; C = (st & 1) * 32 + (swz % 64) / 2; }
__host__ __device__ __forceinline__ int perm32(int rho) { const int n = rho >> 4, i = rho & 15; return 8 * (i >> 2) + 4 * n + (i & 3); }

struct Unit { int pm, pn; };
struct Gemm { const bf16_t* A; const bf16_t* Bt; int M, N, K, lda, ldb, a_shift, a_zoff; };

struct StaticOrder {
    int nM, nN, nwg, G, c;
    __device__ void init(int M, int N, int G_, int c_) { nM = M / BM; nN = N / BM; nwg = nM * nN; G = G_; c = c_; }
    __device__ bool next(int i, Unit& u) const {
        const long L = (long)i * G + c; if (L >= nwg) return false;
        int wgid = (int)L; { const int q = nwg / NXCD, r = nwg % NXCD, xcd = wgid % NXCD, off = wgid / NXCD; wgid = (xcd < r ? xcd * (q + 1) : r * (q + 1) + (xcd - r) * q) + off; }
        const int nig = WGM * nN, gid = wgid / nig, fm = gid * WGM, gsz = (nM - fm) < WGM ? (nM - fm) : WGM;
        u.pm = fm + ((wgid % nig) % gsz); u.pn = (wgid % nig) / gsz; return true;
    }
};

__device__ __forceinline__ unsigned cvt_pk_bf16(float lo, float hi) { unsigned r; asm volatile("v_cvt_pk_bf16_f32 %0, %1, %2" : "=v"(r) : "v"(lo), "v"(hi)); return r; }
__device__ __forceinline__ float bf_lo(unsigned w) { return __uint_as_float(w << 16); }
__device__ __forceinline__ float bf_hi(unsigned w) { return __uint_as_float(w & 0xffff0000u); }

template <int ACT  > struct EpiBf16 {
    static constexpr bool PERM = true;
    bf16_t* O; int ldc;
    __device__ __forceinline__ void operator()(const f32x4 (&acc)[2][2][4][2], const Unit& u, int wr, int wc, int fr, int fq) const {
        const int row0 = u.pm * BM + wr * 64 + fr, col0 = u.pn * BM + wc * 32 + 8 * fq;
#pragma unroll
        for (int ai = 0; ai < 2; ++ai)
#pragma unroll
            for (int m = 0; m < 4; ++m) { bf16_t* rowp = O + (size_t)(row0 + ai * HALF + m * 16) * ldc + col0;
#pragma unroll
                for (int bj = 0; bj < 2; ++bj) { f32x4 v0 = acc[ai][bj][m][0], v1 = acc[ai][bj][m][1];
                    if (ACT == 1) {
#pragma unroll
                        for (int e = 0; e < 4; ++e) { float a = fmaxf(v0[e], 0.f), b = fmaxf(v1[e], 0.f); v0[e] = a * a; v1[e] = b * b; } }
                    u32x4 w; w.x = cvt_pk_bf16(v0[0], v0[1]); w.y = cvt_pk_bf16(v0[2], v0[3]); w.z = cvt_pk_bf16(v1[0], v1[1]); w.w = cvt_pk_bf16(v1[2], v1[3]);
                    *(u32x4*)(rowp + bj * HALF) = w; } }
    }
};
struct EpiMerge {
    static constexpr bool PERM = true;
    const bf16_t* Y; const float* bg; bf16_t* Z;
    __device__ __forceinline__ void operator()(const f32x4 (&acc)[2][2][4][2], const Unit& u, int wr, int wc, int fr, int fq) const {
        const int row0 = u.pm * BM + wr * 64 + fr, dcol = u.pn * 64 + 16 * wc + 4 * fq;
        f32x4 bv[2][2];
#pragma unroll
        for (int bj = 0; bj < 2; ++bj)
#pragma unroll
            for (int n = 0; n < 2; ++n) bv[bj][n] = *(const f32x4*)(bg + (2 * bj + n) * 1024 + dcol);
#pragma unroll
        for (int ai = 0; ai < 2; ++ai)
#pragma unroll
            for (int m = 0; m < 4; ++m) { const size_t r = (size_t)(row0 + ai * HALF + m * 16);
                const bf16_t* yp = Y + r * 4096 + dcol;
                f32x4 z = (f32x4){0.f, 0.f, 0.f, 0.f};
#pragma unroll
                for (int bj = 0; bj < 2; ++bj)
#pragma unroll
                    for (int n = 0; n < 2; ++n) { const u32x2 yw = *(const u32x2*)(yp + (2 * bj + n) * 1024);
                        const f32x4 y = (f32x4){bf_lo(yw.x), bf_hi(yw.x), bf_lo(yw.y), bf_hi(yw.y)};
                        const f32x4 a = acc[ai][bj][m][n] + bv[bj][n];
#pragma unroll
                        for (int e = 0; e < 4; ++e) z[e] += __builtin_amdgcn_rcpf(1.f + __builtin_amdgcn_exp2f(a[e] * -1.4426950408889634f)) * y[e]; }
                u32x2 w; w.x = cvt_pk_bf16(z[0], z[1]); w.y = cvt_pk_bf16(z[2], z[3]);
                *(u32x2*)(Z + r * 1024 + dcol) = w; }
    }
};
struct EpiRes {
    static constexpr bool PERM = false;
    const float* base; float* out; int ldc;
    __device__ __forceinline__ void operator()(const f32x4 (&acc)[2][2][4][2], const Unit& u, int wr, int wc, int fr, int fq) const {
        const int row0 = u.pm * BM + wr * 64 + fr, col0 = u.pn * BM + wc * 32 + 4 * fq;
#pragma unroll
        for (int ai = 0; ai < 2; ++ai)
#pragma unroll
            for (int m = 0; m < 4; ++m) { const size_t off = (size_t)(row0 + ai * HALF + m * 16) * ldc + col0;
#pragma unroll
                for (int bj = 0; bj < 2; ++bj)
#pragma unroll
                    for (int n = 0; n < 2; ++n) { const f32x4 b = *(const f32x4*)(base + off + bj * HALF + n * 16); *(f32x4*)(out + off + bj * HALF + n * 16) = b + acc[ai][bj][m][n]; } }
    }
};

template <class Epi, bool ALIGN_EPI>
__device__ __forceinline__ void gemm_phase(PG8_LAS unsigned char* lds, const Gemm g, const StaticOrder& S, const Epi& E) {
    int tid = threadIdx.x; asm volatile("" : "+v"(tid));
    const int wid = __builtin_amdgcn_readfirstlane(tid >> 6), lane = tid & 63, wr = wid >> 2, wc = wid & 3, fr = lane & 15, fq = lane >> 4;
    const int K = g.K, nt = K / BK;
    unsigned voffA[2], voffB[2];
#pragma unroll
    for (int i = 0; i < 2; ++i) { int R, C; stage_rc(tid * 16 + i * 8192, R, C); const int Rb = Epi::PERM ? ((R & ~31) + perm32(R & 31)) : R;
        voffA[i] = (unsigned)(R * g.lda + C) * 2u; voffB[i] = (unsigned)(Rb * g.ldb + C) * 2u; }
    const size_t kstep = (size_t)(BK * 2);
    const size_t hstepA = (size_t)HALF * g.lda * 2, hstepB = (size_t)HALF * g.ldb * 2;
    const size_t tstepA = 2 * hstepA, tstepB = 2 * hstepB;
    const unsigned ldsw = (unsigned)wid * 1024u;
    const int aoff = lds_byte(wr * 64 + fr, fq * 8), boff = lds_byte(wc * 32 + fr, fq * 8);
#define PG8_SA(b, h) (((b) * 2 + (h)) * HTB)
#define PG8_SB(b, h) ((4 + (b) * 2 + (h)) * HTB)
#define PG8_STAGE(bufoff, gbase, voff) do { _Pragma("unroll") for (int _i = 0; _i < 2; ++_i) \
        __builtin_amdgcn_global_load_lds((const unsigned*)((const char*)(gbase) + (voff)[_i]), (PG8_LAS unsigned*)(lds + (bufoff) + ldsw + _i * 8192), 16, 0, 0); } while (0)
#define PG8_LDA(dst, b, h) do { _Pragma("unroll") for (int m = 0; m < 4; ++m) _Pragma("unroll") for (int k = 0; k < 2; ++k) dst[m][k] = *(const PG8_LAS bf16x8*)(lds + PG8_SA(b, h) + aoff + m * 2048 + k * 1024); } while (0)
#define PG8_LDB(dst, b, h) do { _Pragma("unroll") for (int n = 0; n < 2; ++n) _Pragma("unroll") for (int k = 0; k < 2; ++k) dst[n][k] = *(const PG8_LAS bf16x8*)(lds + PG8_SB(b, h) + boff + n * 2048 + k * 1024); } while (0)
#define PG8_MMA(ai, bj, At, Bt) do { __builtin_amdgcn_s_setprio(1); _Pragma("unroll") for (int m = 0; m < 4; ++m) _Pragma("unroll") for (int n = 0; n < 2; ++n) _Pragma("unroll") for (int k = 0; k < 2; ++k) \
        acc[ai][bj][m][n] = __builtin_amdgcn_mfma_f32_16x16x32_bf16(Bt[n][k], At[m][k], acc[ai][bj][m][n], 0, 0, 0); __builtin_amdgcn_s_setprio(0); } while (0)
#define PG8_WAIT_V(n) asm volatile("s_waitcnt vmcnt(" #n ")" ::: "memory")
#define PG8_WAIT_L(n) asm volatile("s_waitcnt lgkmcnt(" #n ")" ::: "memory")
#define PG8_BAR __builtin_amdgcn_s_barrier()
#define PG8_SCHED __builtin_amdgcn_sched_barrier(0)
#define PG8_APTR(uu) ((const char*)g.A + (size_t)(uu).pm * tstepA + (size_t)((uu).pn >> g.a_shift) * (size_t)g.a_zoff * 2)
    Unit cur, nxt; int ui = 0;
    if (!S.next(0, cur)) return;
    f32x4 acc[2][2][4][2];
#pragma unroll
    for (int a = 0; a < 2; ++a)
#pragma unroll
        for (int b = 0; b < 2; ++b)
#pragma unroll
            for (int m = 0; m < 4; ++m)
#pragma unroll
                for (int n = 0; n < 2; ++n) acc[a][b][m][n] = (f32x4){0.f, 0.f, 0.f, 0.f};
    bf16x8 At[4][2], B0[2][2], B1[2][2];
    const char* cA = PG8_APTR(cur); const char* cB = (const char*)g.Bt + (size_t)cur.pn * tstepB;
    PG8_STAGE(PG8_SB(0, 0), cB, voffB); PG8_STAGE(PG8_SB(0, 1), cB + hstepB, voffB); PG8_STAGE(PG8_SA(0, 0), cA, voffA); PG8_STAGE(PG8_SA(0, 1), cA + hstepA, voffA);
    if (wr == 1) PG8_BAR;
    PG8_WAIT_V(2); PG8_BAR;
    PG8_STAGE(PG8_SB(1, 0), cB + kstep, voffB); PG8_STAGE(PG8_SA(1, 0), cA + kstep, voffA); PG8_STAGE(PG8_SB(1, 1), cB + hstepB + kstep, voffB);
    PG8_WAIT_V(6); PG8_BAR;
    for (;;) {
        const bool has_next = S.next(ui + 1, nxt);
        const char* nA = has_next ? PG8_APTR(nxt) : cA; const char* nB = has_next ? (const char*)g.Bt + (size_t)nxt.pn * tstepB : cB;
        for (int t = 0; t < nt; t += 2) {
            const bool last = (t == nt - 2);
            const char* a1 = cA + (size_t)(t + 1) * kstep;
            const char* a2 = last ? nA : cA + (size_t)(t + 2) * kstep; const char* b2 = last ? nB : cB + (size_t)(t + 2) * kstep;
            const char* a3 = a2 + kstep; const char* b3 = b2 + kstep;
            PG8_LDB(B0, 0, 0); PG8_LDB(B1, 0, 1); PG8_SCHED; PG8_LDA(At, 0, 0); PG8_STAGE(PG8_SA(1, 1), a1 + hstepA, voffA);
            PG8_WAIT_V(8); PG8_WAIT_L(0); PG8_BAR; PG8_MMA(0, 0, At, B0); PG8_MMA(0, 1, At, B1); PG8_BAR; PG8_SCHED;
            PG8_LDA(At, 0, 1); PG8_STAGE(PG8_SB(0, 0), b2, voffB); PG8_STAGE(PG8_SB(0, 1), b2 + hstepB, voffB); PG8_STAGE(PG8_SA(0, 0), a2, voffA);
            PG8_WAIT_V(8); PG8_WAIT_L(0); PG8_BAR; PG8_MMA(1, 0, At, B0); PG8_MMA(1, 1, At, B1); PG8_BAR; PG8_SCHED;
            PG8_LDB(B0, 1, 0); PG8_LDB(B1, 1, 1); PG8_SCHED; PG8_LDA(At, 1, 0); PG8_STAGE(PG8_SA(0, 1), a2 + hstepA, voffA);
            PG8_WAIT_V(8); PG8_WAIT_L(0); PG8_BAR; PG8_MMA(0, 0, At, B0); PG8_MMA(0, 1, At, B1); PG8_BAR; PG8_SCHED;
            PG8_LDA(At, 1, 1); PG8_STAGE(PG8_SB(1, 0), b3, voffB); PG8_STAGE(PG8_SB(1, 1), b3 + hstepB, voffB); PG8_STAGE(PG8_SA(1, 0), a3, voffA);
            PG8_WAIT_V(8); PG8_WAIT_L(0); PG8_BAR; PG8_MMA(1, 0, At, B0); PG8_MMA(1, 1, At, B1); PG8_BAR; PG8_SCHED;
        }
        if constexpr (ALIGN_EPI) { if (wr == 0) PG8_BAR; }
        E(acc, cur, wr, wc, fr, fq);
        if (!has_next) break;
#pragma unroll
        for (int a = 0; a < 2; ++a)
#pragma unroll
            for (int b = 0; b < 2; ++b)
#pragma unroll
                for (int m = 0; m < 4; ++m)
#pragma unroll
                    for (int n = 0; n < 2; ++n) acc[a][b][m][n] = (f32x4){0.f, 0.f, 0.f, 0.f};
        cur = nxt; cA = nA; cB = nB; ++ui;
        if constexpr (ALIGN_EPI) { if (wr == 1) PG8_BAR; }
    }
    PG8_WAIT_V(0);
    if constexpr (!ALIGN_EPI) { if (wr == 0) PG8_BAR; }
    PG8_BAR;
#undef PG8_SA
#undef PG8_SB
#undef PG8_STAGE
#undef PG8_LDA
#undef PG8_LDB
#undef PG8_MMA
#undef PG8_WAIT_V
#undef PG8_WAIT_L
#undef PG8_BAR
#undef PG8_SCHED
#undef PG8_APTR
}
}

namespace att {
typedef unsigned short bf16_t;
typedef short bf16x8 __attribute__((ext_vector_type(8)));
typedef short s16x4 __attribute__((ext_vector_type(4)));
typedef float f32x16 __attribute__((ext_vector_type(16)));
typedef float f32x4 __attribute__((ext_vector_type(4)));
typedef unsigned u32x4 __attribute__((ext_vector_type(4)));
typedef unsigned u32x2 __attribute__((ext_vector_type(2)));
constexpr int SHM_V = 8192, SHM_K = 16384;
constexpr int OFF_V = 0, OFF_K = 2 * SHM_V, OFF_WS = OFF_K + 2 * SHM_K, OFF_TAB = OFF_WS + 2048, OFF_OST = OFF_TAB + 2048, LDS_BYTES = OFF_OST + 8 * 4096;
constexpr float LOG2E = 1.4426950408889634f;
constexpr float THR2 = 8.f * LOG2E;
#define SBAR() __builtin_amdgcn_sched_barrier(0)
__device__ __forceinline__ int crow(int r, int hi) { return (r & 3) + 8 * (r >> 2) + 4 * hi; }
__device__ __forceinline__ unsigned cvtpk(float lo, float hi) { unsigned r; asm volatile("v_cvt_pk_bf16_f32 %0, %1, %2" : "=v"(r) : "v"(lo), "v"(hi)); return r; }
__device__ __forceinline__ float bf_lo(unsigned w) { return __uint_as_float(w << 16); }
__device__ __forceinline__ float bf_hi(unsigned w) { return __uint_as_float(w & 0xffff0000u); }

struct UnitP {
    const bf16_t* Q; const bf16_t* K; const bf16_t* V; bf16_t* O;
    const bf16_t* K2;
    int ldq, ldk, ldv, ldo;
    int t_lo, nt;
    int q0;
    float cscale;
    float slope2, sink2;
    const float* cosT; const float* sinT;
};

template <int DQK> __device__ __forceinline__ int kaddr(int row, int chunk) {
    if (DQK == 64) return row * 128 + ((chunk ^ ((row >> 1) & 7)) << 4);
    else return row * 256 + ((chunk ^ (row & 15)) << 4);
}
__device__ __forceinline__ int v_st(int k, int c) { const int kk = (k & ~0xC) | ((k & 4) << 1) | ((k & 8) >> 1); return ((kk >> 3) * 2 + (c >> 5)) * 512 + ((kk & 7) * 32 + (c & 31)) * 2; }
__device__ __forceinline__ int v_rd_base(int lane) { return ((lane & 3) << 3) | (((lane >> 2) & 3) << 6) | (((lane >> 4) & 1) << 5) | (((lane >> 5) & 1) << 8); }
constexpr int v_rd_off(int d0, int ks, int half) { return d0 * 512 + ks * 2048 + half * 1024; }
template <int OFF> __device__ __forceinline__ s16x4 tr_read(int vb) { s16x4 r; asm volatile("ds_read_b64_tr_b16 %0, %1 offset:%2" : "=&v"(r) : "v"(vb), "i"(OFF) : "memory"); return r; }
template <int D0> __device__ __forceinline__ void pv_one(f32x16& od, int vb, bf16x8 pa0, bf16x8 pa1, bf16x8 pa2, bf16x8 pa3) {
    const s16x4 l0 = tr_read<v_rd_off(D0, 0, 0)>(vb), h0 = tr_read<v_rd_off(D0, 0, 1)>(vb), l1 = tr_read<v_rd_off(D0, 1, 0)>(vb), h1 = tr_read<v_rd_off(D0, 1, 1)>(vb);
    const s16x4 l2 = tr_read<v_rd_off(D0, 2, 0)>(vb), h2 = tr_read<v_rd_off(D0, 2, 1)>(vb), l3 = tr_read<v_rd_off(D0, 3, 0)>(vb), h3 = tr_read<v_rd_off(D0, 3, 1)>(vb);
    asm volatile("s_waitcnt lgkmcnt(0)" ::: "memory"); SBAR();
#define PK(L, H) (bf16x8){L[0], L[1], L[2], L[3], H[0], H[1], H[2], H[3]}
    od = __builtin_amdgcn_mfma_f32_32x32x16_bf16(pa0, PK(l0, h0), od, 0, 0, 0);
    od = __builtin_amdgcn_mfma_f32_32x32x16_bf16(pa1, PK(l1, h1), od, 0, 0, 0);
    od = __builtin_amdgcn_mfma_f32_32x32x16_bf16(pa2, PK(l2, h2), od, 0, 0, 0);
    od = __builtin_amdgcn_mfma_f32_32x32x16_bf16(pa3, PK(l3, h3), od, 0, 0, 0);
#undef PK
}
__device__ __forceinline__ void partialSM(f32x16& p0, f32x16& p1, float& m_reg, float& alpha) {
    float pmax = p0[0];
#pragma unroll
    for (int r = 1; r < 16; ++r) pmax = fmaxf(pmax, p0[r]);
#pragma unroll
    for (int r = 0; r < 16; ++r) pmax = fmaxf(pmax, p1[r]);
    { auto rr = __builtin_amdgcn_permlane32_swap(__float_as_uint(pmax), __float_as_uint(pmax), false, false);
      pmax = fmaxf(__uint_as_float(rr[0]), __uint_as_float(rr[1])); }
    float mn;
    if (__builtin_expect(__all(pmax - m_reg <= THR2), 1)) { mn = m_reg; alpha = 1.f; }
    else { mn = fmaxf(m_reg, pmax); alpha = __builtin_amdgcn_exp2f(m_reg - mn); m_reg = mn; }
#pragma unroll
    for (int r = 0; r < 16; ++r) p0[r] = p0[r] - mn;
#pragma unroll
    for (int r = 0; r < 16; ++r) p1[r] = p1[r] - mn;
#pragma unroll
    for (int r = 0; r < 16; ++r) p0[r] = __builtin_amdgcn_exp2f(p0[r]);
}
__device__ __forceinline__ void finishSM(f32x16& p0, f32x16& p1, float alpha, float& l_reg, bf16x8& pa0, bf16x8& pa1, bf16x8& pa2, bf16x8& pa3) {
#pragma unroll
    for (int r = 0; r < 16; ++r) p1[r] = __builtin_amdgcn_exp2f(p1[r]);
    float ps = 0;
#pragma unroll
    for (int r = 0; r < 16; ++r) ps += p0[r];
#pragma unroll
    for (int r = 0; r < 16; ++r) ps += p1[r];
    { auto rr = __builtin_amdgcn_permlane32_swap(__float_as_uint(ps), __float_as_uint(ps), false, false);
      ps = __uint_as_float(rr[0]) + __uint_as_float(rr[1]); }
    l_reg = l_reg * alpha + ps;
#define PK4(P, BASE, OUT) do { unsigned a0 = cvtpk(P[BASE + 0], P[BASE + 1]), a1 = cvtpk(P[BASE + 2], P[BASE + 3]);   \
    unsigned b0 = cvtpk(P[BASE + 4], P[BASE + 5]), b1 = cvtpk(P[BASE + 6], P[BASE + 7]);                              \
    auto r0 = __builtin_amdgcn_permlane32_swap(a0, b0, false, false); auto r1 = __builtin_amdgcn_permlane32_swap(a1, b1, false, false); \
    u32x4 w = {r0[0], r1[0], r0[1], r1[1]}; OUT = *reinterpret_cast<bf16x8*>(&w); } while (0)
    PK4(p0, 0, pa0); PK4(p0, 8, pa1); PK4(p1, 0, pa2); PK4(p1, 8, pa3);
#undef PK4
}
__device__ __forceinline__ float rowmax32(const f32x16& p0, const f32x16& p1) {
    float pmax = p0[0];
#pragma unroll
    for (int r = 1; r < 16; ++r) pmax = fmaxf(pmax, p0[r]);
#pragma unroll
    for (int r = 0; r < 16; ++r) pmax = fmaxf(pmax, p1[r]);
    auto rr = __builtin_amdgcn_permlane32_swap(__float_as_uint(pmax), __float_as_uint(pmax), false, false);
    return fmaxf(__uint_as_float(rr[0]), __uint_as_float(rr[1]));
}
template <bool FIRST> __device__ __forceinline__ void partialSM_fast(f32x16& p0, f32x16& p1, float& m_reg, f32x16& negm, float& alpha) {
    const float pmax = rowmax32(p0, p1);
    if (!FIRST && __builtin_expect(__all(pmax <= THR2), 1)) { alpha = 1.f; }
    else { const float dl = FIRST ? pmax : fmaxf(pmax, 0.f); m_reg += dl;
#pragma unroll
        for (int r = 0; r < 16; ++r) { p0[r] -= dl; p1[r] -= dl; }
#pragma unroll
        for (int r = 0; r < 16; ++r) negm[r] = -m_reg;
        alpha = __builtin_amdgcn_exp2f(-dl); }
#pragma unroll
    for (int r = 0; r < 16; ++r) p0[r] = __builtin_amdgcn_exp2f(p0[r]);
}
__device__ __forceinline__ void finishSM_fast(f32x16& p0, f32x16& p1, bf16x8& pa0, bf16x8& pa1, bf16x8& pa2, bf16x8& pa3) {
#pragma unroll
    for (int r = 0; r < 16; ++r) p1[r] = __builtin_amdgcn_exp2f(p1[r]);
#define PK4(P, BASE, OUT) do { unsigned a0 = cvtpk(P[BASE + 0], P[BASE + 1]), a1 = cvtpk(P[BASE + 2], P[BASE + 3]);   \
    unsigned b0 = cvtpk(P[BASE + 4], P[BASE + 5]), b1 = cvtpk(P[BASE + 6], P[BASE + 7]);                              \
    auto r0 = __builtin_amdgcn_permlane32_swap(a0, b0, false, false); auto r1 = __builtin_amdgcn_permlane32_swap(a1, b1, false, false); \
    u32x4 w = {r0[0], r1[0], r0[1], r1[1]}; OUT = *reinterpret_cast<bf16x8*>(&w); } while (0)
    PK4(p0, 0, pa0); PK4(p0, 8, pa1); PK4(p1, 0, pa2); PK4(p1, 8, pa3);
#undef PK4
}
__device__ __forceinline__ void pv_ones(f32x16& ol, bf16x8 pa0, bf16x8 pa1, bf16x8 pa2, bf16x8 pa3) {
    const bf16x8 ones = {0x3F80, 0x3F80, 0x3F80, 0x3F80, 0x3F80, 0x3F80, 0x3F80, 0x3F80};
    ol = __builtin_amdgcn_mfma_f32_32x32x16_bf16(pa0, ones, ol, 0, 0, 0);
    ol = __builtin_amdgcn_mfma_f32_32x32x16_bf16(pa1, ones, ol, 0, 0, 0);
    ol = __builtin_amdgcn_mfma_f32_32x32x16_bf16(pa2, ones, ol, 0, 0, 0);
    ol = __builtin_amdgcn_mfma_f32_32x32x16_bf16(pa3, ones, ol, 0, 0, 0);
}
template <int DQK> __device__ __forceinline__ void qkt_neg(f32x16& p0, f32x16& p1, const char* Ks, const bf16x8* qr, const f32x16& negm, int r32, int hi) {
#pragma unroll
    for (int d0 = 0; d0 < DQK / 16; ++d0) {
        const int a0 = kaddr<DQK>(r32, d0 * 2 + hi);
        const bf16x8 b0 = *reinterpret_cast<const bf16x8*>(Ks + a0);
        const bf16x8 b1 = *reinterpret_cast<const bf16x8*>(Ks + a0 + 32 * (DQK == 64 ? 128 : 256));
        if (d0 == 0) { p0 = __builtin_amdgcn_mfma_f32_32x32x16_bf16(b0, qr[0], negm, 0, 0, 0); p1 = __builtin_amdgcn_mfma_f32_32x32x16_bf16(b1, qr[0], negm, 0, 0, 0); }
        else { p0 = __builtin_amdgcn_mfma_f32_32x32x16_bf16(b0, qr[d0], p0, 0, 0, 0); p1 = __builtin_amdgcn_mfma_f32_32x32x16_bf16(b1, qr[d0], p1, 0, 0, 0); } }
}
template <int DQK> __device__ __forceinline__ void qkt(f32x16& p0, f32x16& p1, const char* Ks, const bf16x8* qr, int r32, int hi) {
    p0 = f32x16{}; p1 = f32x16{};
#pragma unroll
    for (int d0 = 0; d0 < DQK / 16; ++d0) {
        const int a0 = kaddr<DQK>(r32, d0 * 2 + hi);
        const bf16x8 b0 = *reinterpret_cast<const bf16x8*>(Ks + a0);
        const bf16x8 b1 = *reinterpret_cast<const bf16x8*>(Ks + a0 + 32 * (DQK == 64 ? 128 : 256));
        p0 = __builtin_amdgcn_mfma_f32_32x32x16_bf16(b0, qr[d0], p0, 0, 0, 0);
        p1 = __builtin_amdgcn_mfma_f32_32x32x16_bf16(b1, qr[d0], p1, 0, 0, 0); }
}
template <int MODE> __device__ __forceinline__ void score_fix(f32x16& p0, f32x16& p1, const UnitP& P, int tt, int wid, int r32, int hi, const float* tab) {
    const float NEG = -INFINITY;
    if (MODE == 2) {
        const int r = (P.q0 >> 6) + (wid >> 1); int c = (wid & 1) * 32 + r32; asm volatile("" : "+v"(c));
        int rs = r - 4; rs = rs < 0 ? 0 : (rs > 248 ? 248 : rs);
        int cs = c - 8; cs = cs < 0 ? 0 : (cs > 48 ? 48 : cs);
        const int kr = tt;
        if (kr < rs || kr > rs + 7) {
#pragma unroll
            for (int x = 0; x < 16; ++x) { p0[x] = NEG; p1[x] = NEG; }
        } else {
            const int ib = (kr - r + 7) * 31 + 15 - c + 4 * hi, wlo = cs - 4 * hi;
#pragma unroll
            for (int x = 0; x < 16; ++x) {
                const int kq = (x & 3) + 8 * (x >> 2);
                const int i0 = ((unsigned)(kq - wlo) < 16u) ? (ib + kq) : 465, i1 = ((unsigned)(kq + 32 - wlo) < 16u) ? (ib + kq + 32) : 465;
                p0[x] = fmaf(p0[x], P.cscale, tab[i0]); p1[x] = fmaf(p1[x], P.cscale, tab[i1]); }
        }
    } else if (MODE == 3) {
        int qpos = P.q0 + wid * 32 + r32; asm volatile("" : "+v"(qpos));
        const int kb = tt * 64, qw = P.q0 + wid * 32;
        if (kb > qw + 31 + 128 || kb + 63 < qw - 128) {
#pragma unroll
            for (int x = 0; x < 16; ++x) { p0[x] = NEG; p1[x] = NEG; }
        } else {
            const float qf = (float)(qpos - kb - 4 * hi), ns = -P.slope2;
#pragma unroll
            for (int x = 0; x < 16; ++x) {
                const float d0 = qf - (float)((x & 3) + 8 * (x >> 2)), d1 = d0 - 32.f;
                const float a0 = fabsf(d0), a1 = fabsf(d1);
                const float v0 = fmaf(a0, ns, p0[x] * P.cscale), v1 = fmaf(a1, ns, p1[x] * P.cscale);
                p0[x] = a0 <= 128.f ? v0 : NEG; p1[x] = a1 <= 128.f ? v1 : NEG; }
        }
    }
}

template <int MODE, bool NM = false>
__device__ __forceinline__ void attn_unit(const UnitP& P, char* lds) {
    constexpr int DQK = (MODE == 1) ? 96 : 64, NQ = DQK / 16, KP = (DQK == 64) ? 128 : 256;
    int tid = threadIdx.x; asm volatile("" : "+v"(tid));
    const int wid = __builtin_amdgcn_readfirstlane(tid >> 6), lane = tid & 63, r32 = lane & 31, hi = lane >> 5;
    char* V_lds = lds + OFF_V; char* K_lds = lds + OFF_K;
    float* ws = (float*)(lds + OFF_WS) + wid * 64; float* li_l = ws; float* al_l = ws + 32;
    const float* tab = (const float*)(lds + OFF_TAB);
    float m_reg = -1e30f, l_reg = 0; f32x16 o[2] = {}; bf16x8 qr[NQ];
    const bf16_t* Qw = P.Q + (size_t)(wid * 32 + r32) * P.ldq + hi * 8;
#pragma unroll
    for (int d0 = 0; d0 < NQ; ++d0) qr[d0] = *reinterpret_cast<const bf16x8*>(Qw + d0 * 16);
    if (MODE == 1) {
        const int pos = P.q0 + wid * 32 + r32;
        const f32x4 c0 = *(const f32x4*)(P.cosT + pos * 16 + hi * 8), c1 = *(const f32x4*)(P.cosT + pos * 16 + hi * 8 + 4);
        const f32x4 s0 = *(const f32x4*)(P.sinT + pos * 16 + hi * 8), s1 = *(const f32x4*)(P.sinT + pos * 16 + hi * 8 + 4);
        const float cc[8] = {c0[0], c0[1], c0[2], c0[3], c1[0], c1[1], c1[2], c1[3]}, ss[8] = {s0[0], s0[1], s0[2], s0[3], s1[0], s1[1], s1[2], s1[3]};
        const float sc = P.cscale;
#pragma unroll
        for (int d0 = 0; d0 < 4; ++d0) { u32x4 w = *reinterpret_cast<u32x4*>(&qr[d0]);
#pragma unroll
            for (int e = 0; e < 4; ++e) w[e] = cvtpk(bf_lo(w[e]) * sc, bf_hi(w[e]) * sc);
            qr[d0] = *reinterpret_cast<bf16x8*>(&w); }
        u32x4 w1 = *reinterpret_cast<u32x4*>(&qr[4]), w2 = *reinterpret_cast<u32x4*>(&qr[5]);
#pragma unroll
        for (int e = 0; e < 4; ++e) {
            const float x1a = bf_lo(w1[e]), x1b = bf_hi(w1[e]), x2a = bf_lo(w2[e]), x2b = bf_hi(w2[e]);
            const float ca = cc[2 * e], cb = cc[2 * e + 1], sa = ss[2 * e], sb = ss[2 * e + 1];
            w1[e] = cvtpk((x1a * ca - x2a * sa) * sc, (x1b * cb - x2b * sb) * sc);
            w2[e] = cvtpk((x2a * ca + x1a * sa) * sc, (x2b * cb + x1b * sb) * sc); }
        qr[4] = *reinterpret_cast<bf16x8*>(&w1); qr[5] = *reinterpret_cast<bf16x8*>(&w2);
    }
    const int srow = tid >> 3, sch = tid & 7;
    const int kst0 = kaddr<DQK>(srow, sch), kst1 = kaddr<DQK>(srow, 8 + (sch >> 1)) + (sch & 1) * 8, vst = v_st(srow, sch * 8);
    const int vb0 = (int)(uintptr_t)V_lds + v_rd_base(lane);
    const bf16_t* Kg = P.K + (size_t)srow * P.ldk + sch * 8;
    const bf16_t* Kg2 = P.K2 + (size_t)srow * 32 + sch * 4;
    const bf16_t* Vg = P.V + (size_t)srow * P.ldv + sch * 8;
    struct { u32x4 k0; u32x2 k1; u32x4 v; } sr_[2];
#define SLOAD(i, tile) do { const size_t _k = (size_t)(tile) * 64; sr_[i].k0 = *(const u32x4*)(Kg + _k * P.ldk); if (DQK == 96) sr_[i].k1 = *(const u32x2*)(Kg2 + _k * 32); \
    sr_[i].v = *(const u32x4*)(Vg + _k * P.ldv); } while (0)
#define SWRITE(b, i) do { *(u32x4*)(K_lds + (b) * SHM_K + kst0) = sr_[i].k0; if (DQK == 96) *(u32x2*)(K_lds + (b) * SHM_K + kst1) = sr_[i].k1; \
    *(u32x4*)(V_lds + (b) * SHM_V + vst) = sr_[i].v; } while (0)
#define SWAIT() do { if (DQK == 96) asm volatile("s_waitcnt vmcnt(3)" ::: "memory"); else asm volatile("s_waitcnt vmcnt(2)" ::: "memory"); } while (0)
#define RESC(a) do { if (__any((a) < 1.f)) { if (hi == 0) al_l[r32] = (a); asm volatile("s_waitcnt lgkmcnt(0)" ::: "memory"); \
    _Pragma("unroll") for (int d = 0; d < 2; ++d) _Pragma("unroll") for (int r = 0; r < 16; ++r) o[d][r] *= al_l[crow(r, hi)]; } } while (0)
#define FIX(p0, p1, tt) do { if (MODE >= 2) score_fix<MODE>(p0, p1, P, (tt), wid, r32, hi, tab); } while (0)
    f32x16 pA0, pA1, pB0, pB1; float alA, alB; bf16x8 pa0, pa1, pa2, pa3; const int NT = P.nt, T0 = P.t_lo;
    constexpr int SE = 0, SO = 1;
    constexpr bool FAST = (MODE < 2);
    f32x16 negm = {}; f32x16 ol = {};
    if (FAST) { m_reg = 0.f; asm volatile("" : "+v"(negm)); }
#define QKT(p0, p1, kb, tt) do { if (FAST) qkt_neg<DQK>(p0, p1, (kb), qr, negm, r32, hi); else { qkt<DQK>(p0, p1, (kb), qr, r32, hi); FIX(p0, p1, (tt)); } } while (0)
#define PSM(p0, p1, al) do { if (NM) { _Pragma("unroll") for (int r_ = 0; r_ < 16; ++r_) p0[r_] = __builtin_amdgcn_exp2f(p0[r_]); } else if (FAST) partialSM_fast<false>(p0, p1, m_reg, negm, al); else partialSM(p0, p1, m_reg, al); } while (0)
#define FSM(p0, p1, al) do { if (FAST) finishSM_fast(p0, p1, pa0, pa1, pa2, pa3); else finishSM(p0, p1, al, l_reg, pa0, pa1, pa2, pa3); } while (0)
#define PVT(vb) do { pv_one<0>(o[0], (vb), pa0, pa1, pa2, pa3); pv_one<1>(o[1], (vb), pa0, pa1, pa2, pa3); if (FAST) pv_ones(ol, pa0, pa1, pa2, pa3); } while (0)
#define RESC2(a) do { if (!NM && __any((a) < 1.f)) { if (hi == 0) al_l[r32] = (a); asm volatile("s_waitcnt lgkmcnt(0)" ::: "memory"); \
    _Pragma("unroll") for (int r = 0; r < 16; ++r) { const float f_ = al_l[crow(r, hi)]; o[0][r] *= f_; o[1][r] *= f_; if (FAST) ol[r] *= f_; } } } while (0)
    SLOAD(SE, T0); asm volatile("s_waitcnt vmcnt(0)" ::: "memory"); SWRITE(0, SE); __syncthreads();
    if (NM) { qkt_neg<DQK>(pA0, pA1, K_lds, qr, negm, r32, hi); PSM(pA0, pA1, alA); }
    else if (FAST) { qkt_neg<DQK>(pA0, pA1, K_lds, qr, negm, r32, hi); partialSM_fast<true>(pA0, pA1, m_reg, negm, alA); }
    else { qkt<DQK>(pA0, pA1, K_lds, qr, r32, hi); FIX(pA0, pA1, T0); partialSM(pA0, pA1, m_reg, alA); }
    SLOAD(SO, T0 + 1); if (2 < NT) SLOAD(SE, T0 + 2);
    SWAIT(); SWRITE(1, SO); __syncthreads();
    for (int j = 1; j + 1 < NT; j += 2) {
        SBAR(); QKT(pB0, pB1, K_lds + SHM_K, T0 + j);
        FSM(pA0, pA1, alA); SBAR();
        SLOAD(SO, T0 + j + 2); SBAR();
        PVT(vb0); PSM(pB0, pB1, alB);
        __syncthreads(); SWAIT(); SWRITE(0, SE);
        RESC2(alB); __syncthreads();
        SBAR(); QKT(pA0, pA1, K_lds, T0 + j + 1);
        FSM(pB0, pB1, alB); SBAR();
        if (j + 3 < NT) SLOAD(SE, T0 + j + 3); SBAR();
        PVT(vb0 + SHM_V); PSM(pA0, pA1, alA);
        __syncthreads(); SWAIT(); SWRITE(1, SO);
        RESC2(alA); __syncthreads();
    }
    SBAR(); QKT(pB0, pB1, K_lds + SHM_K, T0 + NT - 1);
    FSM(pA0, pA1, alA); SBAR();
    PVT(vb0); PSM(pB0, pB1, alB);
    __syncthreads(); RESC2(alB);
    FSM(pB0, pB1, alB); SBAR();
    PVT(vb0 + SHM_V);
    float rli[16];
    if (FAST) {
#pragma unroll
        for (int r = 0; r < 16; ++r) rli[r] = __builtin_amdgcn_rcpf(ol[r]);
    } else {
        if (MODE == 3) l_reg += __builtin_amdgcn_exp2f(P.sink2 - m_reg);
        if (hi == 0) li_l[r32] = l_reg; asm volatile("s_waitcnt lgkmcnt(0)" ::: "memory");
#pragma unroll
        for (int r = 0; r < 16; ++r) rli[r] = __builtin_amdgcn_rcpf(li_l[crow(r, hi)]);
    }
    bf16_t* Ow = P.O + (size_t)(wid * 32) * P.ldo;
    { char* stg = lds + OFF_OST + wid * 4096;
#pragma unroll
      for (int r = 0; r < 16; ++r) { const int orow = crow(r, hi);
#pragma unroll
        for (int d0 = 0; d0 < 2; ++d0) { const unsigned w = cvtpk(o[d0][r] * rli[r], 0.f); *(bf16_t*)(stg + (orow * 64 + d0 * 32 + r32) * 2) = (bf16_t)(w & 0xffffu); } }
      asm volatile("s_waitcnt lgkmcnt(0)" ::: "memory");
#pragma unroll
      for (int i = 0; i < 4; ++i) { const int row = i * 8 + (lane >> 3), ch = lane & 7; const u32x4 v = *(const u32x4*)(stg + row * 128 + ch * 16); *(u32x4*)(Ow + (size_t)row * P.ldo + ch * 8) = v; } }
#undef QKT
#undef PSM
#undef FSM
#undef PVT
#undef RESC2
    __syncthreads();
#undef SLOAD
#undef SWRITE
#undef SWAIT
#undef RESC
#undef FIX
}
#undef SBAR
}

typedef unsigned short bf16;
typedef float f32x4 __attribute__((ext_vector_type(4)));
typedef unsigned u32x4 __attribute__((ext_vector_type(4)));
typedef unsigned u32x2 __attribute__((ext_vector_type(2)));
#define LAS __attribute__((address_space(3)))

constexpr int T_TOK = 32768, SEQ = 16384, DM = 1024, FF = 4096, INW = 2144, INWP = 2304, DEPTH = 2;
constexpr float EPS = 1e-6f;
constexpr size_t MiB = 1u << 20;
constexpr size_t WS_COS = 1 * MiB, WS_SIN = 2 * MiB, WS_W = 4 * MiB, W_LAYER = 34 * MiB;
constexpr size_t WO_IN = 0, WO_G = WO_IN + (size_t)INWP * 1024 * 2, WO_D = WO_G + (size_t)4096 * 1024 * 2, WO_B = WO_D + (size_t)1024 * 384 * 2,
                 WO_O = WO_B + (size_t)4096 * 256 * 2, WO_1 = WO_O + (size_t)1024 * 1024 * 2, WO_2 = WO_1 + (size_t)4096 * 1024 * 2, WO_END = WO_2 + (size_t)4096 * 1024 * 2;
static_assert(WO_END <= W_LAYER, "weight map");
constexpr size_t WS_H = 72 * MiB, WS_BR = 136 * MiB, WS_BIG = 200 * MiB, WS_END = 456 * MiB;
constexpr size_t BIG_QKV = 0, BIG_DA = 144 * MiB, BIG_DX = 168 * MiB, BIG_KR = 232 * MiB;
constexpr int LDS_TOTAL = 147456;

#ifndef EN_MASK
#define EN_MASK 0xffff
#endif
#define EN(k) ((EN_MASK >> (k)) & 1)
#ifndef ATT_MASK
#define ATT_MASK 0xf
#endif
#define AEN(k) ((ATT_MASK >> (k)) & 1)
struct Params { const float* in[19]; float* out; unsigned char* ws; int ph_lo, ph_hi; };
constexpr int PAR_OFF = 139264;
__device__ __forceinline__ unsigned long long par_get(LAS unsigned char* lds, int i) {
    volatile LAS unsigned* pp = (volatile LAS unsigned*)(lds + PAR_OFF) + 2 * i;
    const unsigned lo = __builtin_amdgcn_readfirstlane(pp[0]), hi = __builtin_amdgcn_readfirstlane(pp[1]);
    return ((unsigned long long)hi << 32) | lo;
}
#define PIN(i) (kp.in[(i)])
#define PWS() (kp.ws)
#define POUT() (kp.out)

__device__ __forceinline__ unsigned f2bf(float f) { unsigned u = __builtin_bit_cast(unsigned, f); return (u + 0x7fffu + ((u >> 16) & 1u)) >> 16; }
__device__ __forceinline__ unsigned pk2(float lo, float hi) { return f2bf(lo) | (f2bf(hi) << 16); }
__device__ __forceinline__ float bflo(unsigned w) { return __uint_as_float(w << 16); }
__device__ __forceinline__ float bfhi(unsigned w) { return __uint_as_float(w & 0xffff0000u); }
__device__ __forceinline__ float wave_sum(float v) {
#pragma unroll
    for (int o = 1; o < 64; o <<= 1) v += __shfl_xor(v, o);
    return v;
}


#define XB_TMO      128
#define XB_XCNT(j)  (256  + 64 * (j))
#define XB_XSUB(j)  (1280 + 64 * (j))
#define XB_XGEN(j)  (2304 + 64 * (j))
#define XB_TOP      3328
#define XB_TOPGEN   3392
#define XCD_BAR_WORDS 3456
#define XB_SPIN_CAP (1u << 18)
__device__ __forceinline__ unsigned xb_ld(unsigned* p)              { return __hip_atomic_load(p, __ATOMIC_RELAXED, __HIP_MEMORY_SCOPE_AGENT); }
__device__ __forceinline__ unsigned xb_add(unsigned* p, unsigned v) { return __hip_atomic_fetch_add(p, v, __ATOMIC_RELAXED, __HIP_MEMORY_SCOPE_AGENT); }
__device__ __forceinline__ unsigned xb_xcc_id() { return (unsigned)__builtin_amdgcn_s_getreg((3 << 11) | 20) & 0xFu; }
#define XB_SPIN(cond, bar) do { unsigned _sp = 0; while (cond) { __builtin_amdgcn_s_sleep(1); \
    if ((++_sp & 255u) == 0u) { if (xb_ld(&(bar)[XB_TMO])) break; if (_sp > XB_SPIN_CAP) { atomicAdd(&(bar)[XB_TMO], 1u); break; } } } } while (0)
struct XcdBarrier { unsigned* bar; unsigned x; volatile LAS unsigned* st; };
__device__ __forceinline__ XcdBarrier xcd_barrier_post(unsigned* bar, volatile LAS unsigned* st) {
    XcdBarrier b; b.bar = bar; b.x = xb_xcc_id(); b.st = st;
    if (threadIdx.x == 0) (void)xb_add(&bar[XB_XCNT(b.x)], 1u);
    return b;
}
__device__ __forceinline__ void xcd_barrier_complete(unsigned* bar, unsigned x, unsigned& nloc, unsigned& nx) {
    const unsigned G = gridDim.x * gridDim.y * gridDim.z;
    unsigned sum, cnt, mine, sp = 0u;
    for (;;) {
        sum = 0u; cnt = 0u; mine = 0u;
#pragma unroll
        for (unsigned j = 0; j < 16; ++j) { const unsigned c = xb_ld(&bar[XB_XCNT(j)]); sum += c; cnt += (c > 0u) ? 1u : 0u; mine = (j == x) ? c : mine; }
        if (sum == G) break;
        __builtin_amdgcn_s_sleep(1);
        if ((++sp & 255u) == 0u) { if (xb_ld(&bar[XB_TMO])) break; if (sp > XB_SPIN_CAP) { atomicAdd(&bar[XB_TMO], 1u); break; } }
    }
    nloc = mine > 0u ? mine : 1u; nx = cnt > 0u ? cnt : 1u;
}
__device__ __forceinline__ void xcd_barrier(const XcdBarrier& b) {
    asm volatile("s_waitcnt vmcnt(0)" ::: "memory");
    __syncthreads();
    if (threadIdx.x == 0) {
        unsigned* bar = b.bar;
        __builtin_amdgcn_s_waitcnt(0);
        unsigned nloc = b.st[0], nx = b.st[1];
        if (nloc == 0u) { xcd_barrier_complete(bar, b.x, nloc, nx); b.st[0] = nloc; b.st[1] = nx; }
        const unsigned old = xb_add(&bar[XB_XSUB(b.x)], 1u);
        const unsigned gen = old / nloc;
        if (old + 1u == (gen + 1u) * nloc) {
            __builtin_amdgcn_fence(__ATOMIC_RELEASE, "agent");
            asm volatile("s_waitcnt vmcnt(0)" ::: "memory");
            const unsigned og = xb_add(&bar[XB_TOP], 1u);
            const unsigned tg = og / nx;
            if (og + 1u == (tg + 1u) * nx) xb_add(&bar[XB_TOPGEN], 1u);
            else XB_SPIN(xb_ld(&bar[XB_TOPGEN]) == tg, bar);
            __builtin_amdgcn_fence(__ATOMIC_ACQUIRE, "agent");
            xb_add(&bar[XB_XGEN(b.x)], 1u);
            asm volatile("s_waitcnt vmcnt(0)" ::: "memory");
        } else {
            XB_SPIN(xb_ld(&bar[XB_XGEN(b.x)]) == gen, bar);
            __builtin_amdgcn_fence(__ATOMIC_ACQUIRE, "agent");
            asm volatile("s_waitcnt vmcnt(0)" ::: "memory");
        }
    }
    __syncthreads();
}

template <bool GATE>
__device__ __forceinline__ void tr_item(const float* src, int ldsrc, int k0s, int n0s, bf16* dst, int lddst, int k0d, int n0d, LAS float* scr, int lane) {
#pragma unroll 8
    for (int i = 0; i < 32; ++i) { const int kk = 2 * i + (lane >> 5); scr[kk * 33 + (lane & 31)] = src ? src[(size_t)(k0s + kk) * ldsrc + n0s + (lane & 31)] : 0.f; }
    asm volatile("s_waitcnt lgkmcnt(0)" ::: "memory");
    const int c = lane & 7;
#pragma unroll
    for (int j = 0; j < 4; ++j) { const int n = (lane >> 3) + 8 * j; const LAS float* s = scr + (8 * c) * 33 + n;
        u32x4 o; o.x = pk2(s[0 * 33], s[1 * 33]); o.y = pk2(s[2 * 33], s[3 * 33]); o.z = pk2(s[4 * 33], s[5 * 33]); o.w = pk2(s[6 * 33], s[7 * 33]);
        int drow = n0d + n;
        if (GATE) { const int nb = drow >> 10, d = drow & 1023, dl = d & 63; drow = (d >> 6) * 256 + 128 * (nb >> 1) + 32 * (dl >> 4) + 8 * ((dl >> 2) & 3) + 4 * (nb & 1) + (dl & 3); }
        *(u32x4*)(dst + (size_t)drow * lddst + k0d + 8 * c) = o; }
    asm volatile("s_waitcnt lgkmcnt(0)" ::: "memory");
}

__device__ __forceinline__ void phase_prologue(const Params& kp, LAS unsigned char* lds, int gw, int NGW, int wave, int lane) {
    asm volatile("" : "+v"(lane)); asm volatile("" : "+s"(gw));
    asm volatile("" : "+s"(wave));
    unsigned char* const ws_ = PWS();
    LAS float* scr = (LAS float*)(lds + wave * 16384);
    constexpr int I_IN = 16 * 67, I_INZ = 16 * 5, I_G = 16 * 128, I_D = 6 * 32, I_B = 4 * 4 * 32, I_O = 16 * 32, I_1 = 16 * 128, I_2 = 64 * 32;
    constexpr int PER = I_IN + I_INZ + I_G + I_D + I_B + I_O + I_1 + I_2;
    for (int it = gw; it < DEPTH * PER; it += NGW) {
        const int l = it / PER; int r = it % PER;
        unsigned char* wb = ws_ + WS_W + (size_t)l * W_LAYER;
        if (r < I_IN) { const int kb = r / 67, nb = r % 67; tr_item<false>(PIN(2) + (size_t)l * 1024 * INW, INW, kb * 64, nb * 32, (bf16*)(wb + WO_IN), 1024, kb * 64, nb * 32, scr, lane); continue; } r -= I_IN;
        if (r < I_INZ) { const int kb = r / 5, nb = r % 5; tr_item<false>(nullptr, 0, 0, 0, (bf16*)(wb + WO_IN), 1024, kb * 64, INW + nb * 32, scr, lane); continue; } r -= I_INZ;
        if (r < I_G) { const int kb = r / 128, nb = r % 128; tr_item<true>(PIN(3) + (size_t)l * 1024 * 4096, 4096, kb * 64, nb * 32, (bf16*)(wb + WO_G), 1024, kb * 64, nb * 32, scr, lane); continue; } r -= I_G;
        if (r < I_D) { const int kb = r / 32, nb = r % 32; const float* src = nullptr; int ld = 0, k0 = 0, n0 = 0;
            if (nb < 12 && kb < 3) { src = PIN(11) + (size_t)l * 192 * 384; ld = 384; k0 = kb * 64; n0 = nb * 32; }
            else if (nb >= 12 && nb < 28 && (kb == 3 || kb == 4)) { src = PIN(12) + (size_t)l * 128 * 512; ld = 512; k0 = (kb - 3) * 64; n0 = (nb - 12) * 32; }
            tr_item<false>(src, ld, k0, n0, (bf16*)(wb + WO_D), 384, kb * 64, nb * 32, scr, lane); continue; } r -= I_D;
        if (r < I_B) { const int n = r / 128, q = r % 128, kb = q / 32, nb = q % 32;
            tr_item<false>(PIN(13) + ((size_t)l * 4 + n) * 256 * 1024, 1024, kb * 64, nb * 32, (bf16*)(wb + WO_B), 256, kb * 64, n * 1024 + nb * 32, scr, lane); continue; } r -= I_B;
        if (r < I_O) { const int kb = r / 32, nb = r % 32; tr_item<false>(PIN(14) + (size_t)l * 1024 * 1024, 1024, kb * 64, nb * 32, (bf16*)(wb + WO_O), 1024, kb * 64, nb * 32, scr, lane); continue; } r -= I_O;
        if (r < I_1) { const int kb = r / 128, nb = r % 128; tr_item<false>(PIN(16) + (size_t)l * 1024 * 4096, 4096, kb * 64, nb * 32, (bf16*)(wb + WO_1), 1024, kb * 64, nb * 32, scr, lane); continue; } r -= I_1;
        { const int kb = r / 32, nb = r % 32; tr_item<false>(PIN(17) + (size_t)l * 4096 * 1024, 1024, kb * 64, nb * 32, (bf16*)(wb + WO_2), 4096, kb * 64, nb * 32, scr, lane); }
    }
    const float inv[16] = {1.000000000e+00f, 5.623413324e-01f, 3.162277639e-01f, 1.778279394e-01f, 1.000000015e-01f, 5.623413250e-02f, 3.162277490e-02f, 1.778279431e-02f,
                           9.999999776e-03f, 5.623413250e-03f, 3.162277630e-03f, 1.778279431e-03f, 1.000000047e-03f, 5.623413017e-04f, 3.162277571e-04f, 1.778279402e-04f};
    float* cosT = (float*)(ws_ + WS_COS); float* sinT = (float*)(ws_ + WS_SIN);
    for (int idx = gw * 64 + lane; idx < SEQ * 16; idx += NGW * 64) {
        const int pos = idx >> 4, i = idx & 15;
        float iv = inv[0];
#pragma unroll
        for (int q = 1; q < 16; ++q) iv = (i == q) ? inv[q] : iv;
        const float angf = (float)pos * iv;
        const double a = (double)angf;
        const double kq = __builtin_rint(a * 0.15915494309189535);
        double rr = __builtin_fma(-kq, 6.283185307179586, a); rr = __builtin_fma(-kq, 2.4492935982947064e-16, rr);
        const double r2 = rr * rr;
        double sp = -1.0 / 1.0888869450418352e28, cp = 1.0 / 4.0329146112660565e26;
        const double fs[13] = {1.0 / 1.5511210043330986e25, -1.0 / 2.5852016738884978e22, 1.0 / 5.109094217170944e19, -1.0 / 1.21645100408832e17, 1.0 / 3.55687428096e14,
                               -1.0 / 1.307674368e12, 1.0 / 6.2270208e9, -1.0 / 3.99168e7, 1.0 / 3.6288e5, -1.0 / 5.04e3, 1.0 / 1.2e2, -1.0 / 6.0, 1.0};
        const double fc[13] = {-1.0 / 6.204484017332394e23, 1.0 / 1.1240007277776077e21, -1.0 / 2.43290200817664e18, 1.0 / 6.402373705728e15, -1.0 / 2.0922789888e13,
                               1.0 / 8.71782912e10, -1.0 / 4.790016e8, 1.0 / 3.6288e6, -1.0 / 4.032e4, 1.0 / 7.2e2, -1.0 / 2.4e1, 1.0 / 2.0, -1.0};
#pragma unroll
        for (int q = 0; q < 13; ++q) { sp = __builtin_fma(sp, r2, fs[q]); cp = __builtin_fma(cp, r2, fc[q]); }
        cosT[idx] = (float)(-cp); sinT[idx] = (float)(sp * rr);
    }
}

__device__ __forceinline__ void phase_norm(const float* __restrict__ x, const float* __restrict__ g, bf16* __restrict__ out, int gw, int NGW, int lane) {
    asm volatile("" : "+v"(lane)); asm volatile("" : "+s"(gw));
    f32x4 gv[4];
#pragma unroll
    for (int j = 0; j < 4; ++j) gv[j] = ((const f32x4*)g)[lane + 64 * j];
    for (int m = gw; m < T_TOK; m += 2 * NGW) {
        const int m2 = m + NGW;
        const f32x4* xr = (const f32x4*)(x + (size_t)m * DM) + lane;
        const f32x4* xr2 = (const f32x4*)(x + (size_t)(m2 < T_TOK ? m2 : m) * DM) + lane;
        f32x4 v[4], w[4]; float s = 0.f, s2 = 0.f;
#pragma unroll
        for (int j = 0; j < 4; ++j) { v[j] = xr[64 * j]; w[j] = xr2[64 * j]; }
#pragma unroll
        for (int j = 0; j < 4; ++j) { s += (v[j].x * v[j].x + v[j].y * v[j].y) + (v[j].z * v[j].z + v[j].w * v[j].w); s2 += (w[j].x * w[j].x + w[j].y * w[j].y) + (w[j].z * w[j].z + w[j].w * w[j].w); }
        const float rstd = 1.0f / sqrtf(wave_sum(s) * (1.f / DM) + EPS), rstd2 = 1.0f / sqrtf(wave_sum(s2) * (1.f / DM) + EPS);
        u32x2* o8 = (u32x2*)(out + (size_t)m * DM) + lane;
#pragma unroll
        for (int j = 0; j < 4; ++j) { u32x2 q; q.x = pk2(v[j].x * rstd * gv[j].x, v[j].y * rstd * gv[j].y); q.y = pk2(v[j].z * rstd * gv[j].z, v[j].w * rstd * gv[j].w); o8[64 * j] = q; }
        if (m2 < T_TOK) { u32x2* o82 = (u32x2*)(out + (size_t)m2 * DM) + lane;
#pragma unroll
            for (int j = 0; j < 4; ++j) { u32x2 q; q.x = pk2(w[j].x * rstd2 * gv[j].x, w[j].y * rstd2 * gv[j].y); q.y = pk2(w[j].z * rstd2 * gv[j].z, w[j].w * rstd2 * gv[j].w); o82[64 * j] = q; } }
    }
}
__device__ __forceinline__ void phase_final_norm(float* x, const float* g, int gw, int NGW, int lane) {
    asm volatile("" : "+v"(lane)); asm volatile("" : "+s"(gw));
    f32x4 gv[4];
#pragma unroll
    for (int j = 0; j < 4; ++j) gv[j] = ((const f32x4*)g)[lane + 64 * j];
    for (int m = gw; m < T_TOK; m += NGW) {
        f32x4* xr = (f32x4*)(x + (size_t)m * DM) + lane;
        f32x4 v[4]; float s = 0.f;
#pragma unroll
        for (int j = 0; j < 4; ++j) { v[j] = xr[64 * j]; s += (v[j].x * v[j].x + v[j].y * v[j].y) + (v[j].z * v[j].z + v[j].w * v[j].w); }
        const float rstd = 1.0f / sqrtf(wave_sum(s) * (1.f / DM) + EPS);
#pragma unroll
        for (int j = 0; j < 4; ++j) xr[64 * j] = v[j] * rstd * gv[j];
    }
}

__device__ __forceinline__ void phase_prep(const Params& kp, LAS unsigned char* lds, int l, int gw, int NGW, int lane) {
    asm volatile("" : "+v"(lane)); asm volatile("" : "+s"(gw));
    unsigned char* const ws_ = PWS();
    bf16* QKV = (bf16*)(ws_ + WS_BIG + BIG_QKV); bf16* DA = (bf16*)(ws_ + WS_BIG + BIG_DA); bf16* KR = (bf16*)(ws_ + WS_BIG + BIG_KR);
    const float* cosT = (const float*)(ws_ + WS_COS); const float* sinT = (const float*)(ws_ + WS_SIN);
    const float* gq = PIN(5) + l * 64; const float* gk = PIN(6) + l * 64; const float* gdq = PIN(9) + l * 192; const float* gdkv = PIN(10) + l * 128;
    const int m16 = lane & 15;
    const f32x4 gq4 = *(const f32x4*)(gq + m16 * 4), gk4 = *(const f32x4*)(gk + m16 * 4);
    const f32x4 gdq4 = lane < 48 ? *(const f32x4*)(gdq + lane * 4) : (f32x4){0.f, 0.f, 0.f, 0.f};
    const f32x4 gdkv4 = lane < 32 ? *(const f32x4*)(gdkv + lane * 4) : (f32x4){0.f, 0.f, 0.f, 0.f};
    const float CA = 0.125f * 1.4426950408889634f;
    for (int t = gw; t < T_TOK; t += NGW) {
        bf16* row = QKV + (size_t)t * INWP;
        const int tin = t & (SEQ - 1), prow = tin >> 6, pcol = tin & 63;
        const int blk = m16 >> 3, i0 = (m16 & 7) * 4, ti = i0 & 15; const bool isx2 = i0 >= 16;
        const int posA = blk ? pcol : prow;
        const u32x2 wq = *(const u32x2*)(row + 4 * lane);
        const u32x2 wk = lane < 32 ? *(const u32x2*)(row + 256 + 4 * lane) : (u32x2){0u, 0u};
        const u32x2 wcq = lane < 48 ? *(const u32x2*)(row + 1792 + 4 * lane) : (u32x2){0u, 0u};
        const u32x2 wckv = lane < 32 ? *(const u32x2*)(row + 1984 + 4 * lane) : (u32x2){0u, 0u};
        const u32x2 wkr = lane < 8 ? *(const u32x2*)(row + 2112 + 4 * lane) : (u32x2){0u, 0u};
        const f32x4 cA = *(const f32x4*)(cosT + posA * 16 + ti), sA = *(const f32x4*)(sinT + posA * 16 + ti);
        const f32x4 cD = *(const f32x4*)(cosT + tin * 16 + ti), sD = *(const f32x4*)(sinT + tin * 16 + ti);
#pragma unroll
        for (int pass = 0; pass < 2; ++pass) {
            const bool act = (pass == 0) || (lane < 32);
            bf16* ptr = row + pass * 256 + 4 * lane;
            const u32x2 w = pass == 0 ? wq : wk;
            float x[4] = {bflo(w.x), bfhi(w.x), bflo(w.y), bfhi(w.y)};
            float ss = (x[0] * x[0] + x[1] * x[1]) + (x[2] * x[2] + x[3] * x[3]);
            ss += __shfl_xor(ss, 1); ss += __shfl_xor(ss, 2); ss += __shfl_xor(ss, 4); ss += __shfl_xor(ss, 8);
            const float rstd = 1.0f / sqrtf(ss * (1.f / 64.f) + EPS);
            const f32x4 g4 = pass == 0 ? gq4 : gk4;
            float y[4], o[4];
#pragma unroll
            for (int e = 0; e < 4; ++e) y[e] = x[e] * rstd * g4[e];
#pragma unroll
            for (int e = 0; e < 4; ++e) { const float pr = __shfl_xor(y[e], 4); o[e] = isx2 ? (y[e] * cA[e] + pr * sA[e]) : (y[e] * cA[e] - pr * sA[e]); if (pass == 0) o[e] *= CA; }
            if (act) { u32x2 ow; ow.x = pk2(o[0], o[1]); ow.y = pk2(o[2], o[3]); *(u32x2*)ptr = ow; }
        }
        {
            float x[4] = {bflo(wcq.x), bfhi(wcq.x), bflo(wcq.y), bfhi(wcq.y)};
            const float ss = wave_sum((x[0] * x[0] + x[1] * x[1]) + (x[2] * x[2] + x[3] * x[3]));
            const float rstd = 1.0f / sqrtf(ss * (1.f / 192.f) + EPS);
            if (lane < 48) { u32x2 ow; ow.x = pk2(x[0] * rstd * gdq4[0], x[1] * rstd * gdq4[1]); ow.y = pk2(x[2] * rstd * gdq4[2], x[3] * rstd * gdq4[3]); *(u32x2*)(DA + (size_t)t * 384 + 4 * lane) = ow; }
        }
        {
            float x[4] = {bflo(wckv.x), bfhi(wckv.x), bflo(wckv.y), bfhi(wckv.y)};
            const float ss = wave_sum((x[0] * x[0] + x[1] * x[1]) + (x[2] * x[2] + x[3] * x[3]));
            const float rstd = 1.0f / sqrtf(ss * (1.f / 128.f) + EPS);
            u32x2 ow; ow.x = pk2(x[0] * rstd * gdkv4[0], x[1] * rstd * gdkv4[1]); ow.y = pk2(x[2] * rstd * gdkv4[2], x[3] * rstd * gdkv4[3]);
            if (lane >= 32) { ow.x = 0u; ow.y = 0u; }
            if (lane < 48) *(u32x2*)(DA + (size_t)t * 384 + 192 + 4 * lane) = ow;
        }
        {
            float x[4] = {bflo(wkr.x), bfhi(wkr.x), bflo(wkr.y), bfhi(wkr.y)};
            float o[4];
#pragma unroll
            for (int e = 0; e < 4; ++e) { const float pr = __shfl_xor(x[e], 4); o[e] = isx2 ? (x[e] * cD[e] + pr * sD[e]) : (x[e] * cD[e] - pr * sD[e]); }
            if (lane < 8) { u32x2 ow; ow.x = pk2(o[0], o[1]); ow.y = pk2(o[2], o[3]); *(u32x2*)(KR + (size_t)t * 32 + 4 * lane) = ow; }
        }
    }
}

__device__ __forceinline__ void phase_attention(const Params& kp, LAS unsigned char* lds, int l, char* ldsg, int vcu, int G) {
    asm volatile("" : "+s"(vcu));
    unsigned char* const ws_ = PWS();
    const bf16* QKV = (const bf16*)(ws_ + WS_BIG + BIG_QKV); const bf16* DX = (const bf16*)(ws_ + WS_BIG + BIG_DX); const bf16* KR = (const bf16*)(ws_ + WS_BIG + BIG_KR);
    bf16* BR = (bf16*)(ws_ + WS_BR);
    const int upc = (512 + G - 1) / G, u0 = vcu * upc, u1 = (u0 + upc) < 512 ? (u0 + upc) : 512;
    const float L2E = 1.4426950408889634f;
    att::UnitP P;
    P.cosT = (const float*)(ws_ + WS_COS); P.sinT = (const float*)(ws_ + WS_SIN); P.slope2 = 0.f; P.sink2 = 0.f; P.cscale = 1.f; P.K2 = nullptr;
    bool nomaxA;
    { const int ln = threadIdx.x & 63; float gq = fabsf(PIN(5)[l * 64 + ln]), gk = fabsf(PIN(6)[l * 64 + ln]);
#pragma unroll
      for (int o_ = 1; o_ < 64; o_ <<= 1) { gq = fmaxf(gq, __shfl_xor(gq, o_)); gk = fmaxf(gk, __shfl_xor(gk, o_)); }
      const float bound2 = 8.f * gq * gk * L2E * 1.02f;
      nomaxA = __builtin_amdgcn_readfirstlane(bound2 <= 40.f ? 1 : 0) != 0; }
    if (AEN(0)) for (int u = u0; u < u1; ++u) { const int bh = u >> 6, qb = u & 63, b = bh >> 2, h = bh & 3; const size_t r0 = (size_t)b * SEQ;
        P.Q = QKV + (r0 + qb * 256) * INWP + h * 64; P.K = QKV + r0 * INWP + 256 + (h >> 1) * 64; P.V = QKV + r0 * INWP + 384 + (h >> 1) * 64; P.O = BR + (r0 + qb * 256) * 1024 + h * 64;
        P.ldq = INWP; P.ldk = INWP; P.ldv = INWP; P.ldo = 1024; P.t_lo = 0; P.nt = 256; P.q0 = qb * 256;
        if (nomaxA) att::attn_unit<0, true>(P, ldsg); else att::attn_unit<0, false>(P, ldsg); }
    if (AEN(1)) for (int u = u0; u < u1; ++u) { const int bh = u >> 6, qb = u & 63, b = bh >> 2, h = bh & 3; const size_t r0 = (size_t)b * SEQ;
        P.Q = DX + (r0 + qb * 256) * 1024 + h * 96; P.K = DX + r0 * 1024 + 384 + h * 128; P.V = DX + r0 * 1024 + 384 + h * 128 + 64; P.K2 = KR + r0 * 32; P.O = BR + (r0 + qb * 256) * 1024 + 768 + h * 64;
        P.ldq = 1024; P.ldk = 1024; P.ldv = 1024; P.ldo = 1024; P.t_lo = 0; P.nt = 256; P.q0 = qb * 256; P.cscale = 0.10206207261596575f * L2E;
        att::attn_unit<1>(P, ldsg); }
    if (AEN(3)) for (int u = u0; u < u1; ++u) { const int bh = u >> 6, qb = u & 63, b = bh >> 2, h = bh & 3; const size_t r0 = (size_t)b * SEQ;
        P.Q = QKV + (r0 + qb * 256) * INWP + 1280 + h * 64; P.K = QKV + r0 * INWP + 1536 + (h >> 1) * 64; P.V = QKV + r0 * INWP + 1664 + (h >> 1) * 64; P.O = BR + (r0 + qb * 256) * 1024 + 512 + h * 64;
        P.ldq = INWP; P.ldk = INWP; P.ldv = INWP; P.ldo = 1024; P.q0 = qb * 256;
        int lo = qb * 4 - 2, hi = qb * 4 + 6; lo = lo < 0 ? 0 : lo; hi = hi > 256 ? 256 : hi; P.t_lo = lo; P.nt = hi - lo;
        P.cscale = 0.125f * L2E; P.slope2 = __builtin_amdgcn_exp2f(-2.f * (float)(h + 1)) * L2E; P.sink2 = PIN(8)[l * 4 + h] * L2E;
        att::attn_unit<3>(P, ldsg); }
    if (AEN(2)) for (int u = u0; u < u1; ++u) { const int bh = u >> 6, qb = u & 63, b = bh >> 2, h = bh & 3; const size_t r0 = (size_t)b * SEQ;
        { float* tab = (float*)(ldsg + att::OFF_TAB); const float* src = PIN(7) + ((size_t)l * 4 + h) * 465;
          for (int i = threadIdx.x; i < 466; i += 512) tab[i] = i < 465 ? src[i] * L2E : -INFINITY;
          __syncthreads(); }
        P.Q = QKV + (r0 + qb * 256) * INWP + 512 + h * 64; P.K = QKV + r0 * INWP + 768 + h * 64; P.V = QKV + r0 * INWP + 1024 + h * 64; P.O = BR + (r0 + qb * 256) * 1024 + 256 + h * 64;
        P.ldq = INWP; P.ldk = INWP; P.ldv = INWP; P.ldo = 1024; P.q0 = qb * 256;
        const int ra = qb * 4, rb = qb * 4 + 3;
        int lo = ra - 4; lo = lo < 0 ? 0 : (lo > 248 ? 248 : lo);
        int hi = rb - 4; hi = hi < 0 ? 0 : (hi > 248 ? 248 : hi); hi += 8;
        if ((hi - lo) & 1) { if (hi < 256) ++hi; else --lo; }
        P.t_lo = lo; P.nt = hi - lo; P.cscale = 0.125f * L2E;
        att::attn_unit<2>(P, ldsg); }
}

template <int S_>
__device__ __forceinline__ void run_sub(const Params& kp, int l, LAS unsigned char* lds, unsigned char* lds_raw, int gw, int NGW, int lane, int vcu, int G, int bx) {
    constexpr int s = S_;
    unsigned char* ws = PWS(); float* xres = POUT();
    bf16* H = (bf16*)(ws + WS_H); bf16* BR = (bf16*)(ws + WS_BR); bf16* BIG = (bf16*)(ws + WS_BIG);
    unsigned char* wb = ws + WS_W + (size_t)l * W_LAYER;
    const float* xin = (l == 0) ? PIN(0) : xres;
    pg8::StaticOrder S;
    if constexpr (s == 0) { if (EN(1)) phase_norm(xin, PIN(1) + l * DM, H, gw, NGW, lane); }
    else if constexpr (s == 2) { if (EN(3)) phase_prep(kp, lds, l, gw, NGW, lane); }
    else if constexpr (s == 4) { if (EN(5)) { phase_attention(kp, lds, l, (char*)lds_raw, vcu, G); if (PROBE_DUP == 1 && l == 0) { __syncthreads(); phase_attention(kp, lds, l, (char*)lds_raw, vcu, G); } } }
    else if constexpr (s == 8) { if (EN(9)) phase_norm(xres, PIN(15) + l * DM, H, gw, NGW, lane); }
    else if constexpr (s == 1 || s == 3 || s == 5) {
        if (EN(2)) {
        pg8::Gemm g; pg8::EpiBf16<0> E;
        if (s == 1) { g = pg8::Gemm{H, (const bf16*)(wb + WO_IN), T_TOK, INWP, DM, DM, DM, 30, 0}; E = pg8::EpiBf16<0>{BIG + BIG_QKV / 2, INWP}; }
        else if (s == 3) { g = pg8::Gemm{BIG + BIG_DA / 2, (const bf16*)(wb + WO_D), T_TOK, 1024, 384, 384, 384, 30, 0}; E = pg8::EpiBf16<0>{BIG + BIG_DX / 2, 1024}; }
        else { g = pg8::Gemm{BR, (const bf16*)(wb + WO_B), T_TOK, 4096, 256, 1024, 256, 2, 256}; E = pg8::EpiBf16<0>{BIG, 4096}; }
        S.init(T_TOK, g.N, G, bx);
        pg8::gemm_phase<pg8::EpiBf16<0>, true>(lds, g, S, E); } }
    else if constexpr (s == 6) {
        if (EN(7)) {
        pg8::Gemm g{H, (const bf16*)(wb + WO_G), T_TOK, 4096, DM, DM, DM, 30, 0}; S.init(T_TOK, 4096, G, bx);
        pg8::EpiMerge E{BIG, PIN(4) + (size_t)l * 4096, BR};
        pg8::gemm_phase<pg8::EpiMerge, true>(lds, g, S, E); } }
    else if constexpr (s == 9) {
        if (EN(10)) {
        pg8::Gemm g{H, (const bf16*)(wb + WO_1), T_TOK, FF, DM, DM, DM, 30, 0}; S.init(T_TOK, FF, G, bx);
        pg8::EpiBf16<1> E{BIG, FF};
        pg8::gemm_phase<pg8::EpiBf16<1>, true>(lds, g, S, E);
        if (PROBE_DUP == 2 && l == 0) pg8::gemm_phase<pg8::EpiBf16<1>, true>(lds, g, S, E); } }
    else {
        if (EN(8)) {
        pg8::Gemm g; pg8::EpiRes E;
        if (s == 7) { g = pg8::Gemm{BR, (const bf16*)(wb + WO_O), T_TOK, DM, DM, DM, DM, 30, 0}; E = pg8::EpiRes{xin, xres, DM}; }
        else { g = pg8::Gemm{BIG, (const bf16*)(wb + WO_2), T_TOK, DM, FF, FF, FF, 30, 0}; E = pg8::EpiRes{xres, xres, DM}; }
        S.init(T_TOK, DM, G, bx);
        pg8::gemm_phase<pg8::EpiRes, true>(lds, g, S, E); } }
}

__global__ void __launch_bounds__(512, 2) fwd_megakernel(Params p) {
    extern __shared__ __attribute__((aligned(16))) unsigned char lds_raw[];
    cg::grid_group grid = cg::this_grid();
    LAS unsigned char* lds = (LAS unsigned char*)lds_raw;
    const int tid = threadIdx.x, lane = tid & 63, wave = __builtin_amdgcn_readfirstlane(tid >> 6);
    const int G = gridDim.x, bx = blockIdx.x;
    const int vcu = (G % 8 == 0) ? (bx % 8) * (G / 8) + bx / 8 : bx;
    const int gw = vcu * 8 + wave, NGW = G * 8;
    const int ph_lo = p.ph_lo, ph_hi = p.ph_hi;
    volatile LAS unsigned* MISC = (volatile LAS unsigned*)(lds + PAR_OFF);
    if (tid < 2) MISC[tid] = 0u;
    __syncthreads();
    const XcdBarrier xbar = xcd_barrier_post((unsigned*)p.ws, MISC);
#define RUN_PH(ph, ...) do { if (ph_lo <= (ph) && (ph) < ph_hi) { __VA_ARGS__; if ((ph) + 1 < ph_hi) { if ((ph) == 0) grid.sync(); else xcd_barrier(xbar); } } } while (0)
#define RUN_SUB(L, S_) RUN_PH(1 + (L) * 11 + (S_), run_sub<S_>(p, (L), lds, lds_raw, gw, NGW, lane, vcu, G, bx))
#define RUN_LAYER(L) do { RUN_SUB(L, 0); RUN_SUB(L, 1); RUN_SUB(L, 2); RUN_SUB(L, 3); RUN_SUB(L, 4); RUN_SUB(L, 5); RUN_SUB(L, 6); RUN_SUB(L, 7); RUN_SUB(L, 8); RUN_SUB(L, 9); RUN_SUB(L, 10); } while (0)
    RUN_PH(0, if (EN(0)) phase_prologue(p, lds, gw, NGW, wave, lane));
    RUN_LAYER(0);
    RUN_LAYER(1);
    RUN_PH(23, if (EN(12)) phase_final_norm(p.out, p.in[18], gw, NGW, lane));
}

extern "C" void kernel_launch(void* const* d_in, const int* in_sizes, int n_in, void* d_out, int out_size, void* d_ws, size_t ws_size, hipStream_t stream) {
    static int grid = 0;
    if (grid == 0) {
        if (n_in != 19 || in_sizes[0] != T_TOK * DM || out_size != T_TOK * DM || ws_size < WS_END) {
            fprintf(stderr, "kernel_launch: unexpected shapes (n_in %d, in0 %d, out %d, ws %zu); nothing launched\n", n_in, n_in > 0 ? in_sizes[0] : -1, out_size, ws_size); grid = -1; return; }
        int dev = 0, cus = 0, per_cu = 0;
        if (hipGetDevice(&dev) != hipSuccess || hipDeviceGetAttribute(&cus, hipDeviceAttributeMultiprocessorCount, dev) != hipSuccess) { grid = -1; return; }
        if (hipFuncSetAttribute((const void*)fwd_megakernel, hipFuncAttributeMaxDynamicSharedMemorySize, LDS_TOTAL) != hipSuccess) { fprintf(stderr, "kernel_launch: hipFuncSetAttribute failed\n"); grid = -1; return; }
        if (hipOccupancyMaxActiveBlocksPerMultiprocessor(&per_cu, (const void*)fwd_megakernel, 512, LDS_TOTAL) != hipSuccess || per_cu < 1) { fprintf(stderr, "kernel_launch: occupancy query failed (%d)\n", per_cu); per_cu = 1; }
        (void)hipGetLastError();
        grid = cus * per_cu;
    }
    if (grid < 0) return;
    if (hipMemsetAsync(d_ws, 0, 16384, stream) != hipSuccess) { fprintf(stderr, "kernel_launch: memset of the barrier words failed\n"); return; }
    Params prm{};
    for (int i = 0; i < 19; ++i) prm.in[i] = (const float*)d_in[i];
    prm.out = (float*)d_out; prm.ws = (unsigned char*)d_ws;
#if MK_PER_PHASE
    for (int ph = 0; ph < 24; ++ph) { prm.ph_lo = ph; prm.ph_hi = ph + 1; void* args[] = {&prm};
        hipError_t e = hipLaunchCooperativeKernel((const void*)fwd_megakernel, dim3(grid), dim3(512), args, LDS_TOTAL, stream);
        if (e != hipSuccess) { fprintf(stderr, "cooperative launch failed: %s (grid %d)\n", hipGetErrorString(e), grid); break; } }
#else
    prm.ph_lo = 0; prm.ph_hi = 24; void* args[] = {&prm};
    hipError_t e = hipLaunchCooperativeKernel((const void*)fwd_megakernel, dim3(grid), dim3(512), args, LDS_TOTAL, stream);
    if (e != hipSuccess) fprintf(stderr, "cooperative launch failed: %s (grid %d)\n", hipGetErrorString(e), grid);
#endif
}
```

```cpp
#include <hip/hip_runtime.h>
#include <hip/hip_cooperative_groups.h>
#include <cstdio>
#include <cstdint>
namespace cg = cooperative_groups;

#ifndef PROBE_DUP
#define PROBE_DUP 0
#endif
#ifndef MK_PER_PHASE
#define MK_PER_PHASE 0
#endif

namespace pg8 {
#define PG8_LAS __attribute__((address_space(3)))
typedef unsigned short bf16_t;
typedef short bf16x8 __attribute__((ext_vector_type(8)));
typedef float f32x4 __attribute__((ext_vector_type(4)));
typedef float f32x2 __attribute__((ext_vector_type(2)));
typedef unsigned u32x4 __attribute__((ext_vector_type(4)));
typedef unsigned u32x2 __attribute__((ext_vector_type(2)));
constexpr int BM = 256, BK = 64, HALF = 128, HTB = HALF * BK * 2, STAGE_BYTES = 8 * HTB, NXCD = 8, WGM = 8;

__host__ __device__ __forceinline__ int lds_byte(int r, int c) { const int st = (r >> 4) * 2 + (c >> 5), rr = r & 15, cc = c & 31, ob = rr * 64 + cc * 2; return st * 1024 + (ob ^ (((ob >> 9) & 1) << 5)); }
__host__ __device__ __forceinline__ void stage_rc(int b, int& R, int& C) { const int st = b / 1024, sb = b % 1024, swz = sb ^ (((sb >> 9) & 1) << 5); R = (st >> 1) * 16 + swz / 64; C = (st & 1) * 32 + (swz % 64) / 2; }
__host__ __device__ __forceinline__ int perm32(int rho) { const int n = rho >> 4, i = rho & 15; return 8 * (i >> 2) + 4 * n + (i & 3); }

struct Unit { int pm, pn; };
struct Gemm { const bf16_t* A; const bf16_t* Bt; int M, N, K, lda, ldb, a_shift, a_zoff; };

struct StaticOrder {
    int nM, nN, nwg, G, c;
    __device__ void init(int M, int N, int G_, int c_) { nM = M / BM; nN = N / BM; nwg = nM * nN; G = G_; c = c_; }
    __device__ bool next(int i, Unit& u) const {
        const long L = (long)i * G + c; if (L >= nwg) return false;
        int wgid = (int)L; { const int q = nwg / NXCD, r = nwg % NXCD, xcd = wgid % NXCD, off = wgid / NXCD; wgid = (xcd < r ? xcd * (q + 1) : r * (q + 1) + (xcd - r) * q) + off; }
        const int nig = WGM * nN, gid = wgid / nig, fm = gid * WGM, gsz = (nM - fm) < WGM ? (nM - fm) : WGM;
        u.pm = fm + ((wgid % nig) % gsz); u.pn = (wgid % nig) / gsz; return true;
    }
};

__device__ __forceinline__ unsigned cvt_pk_bf16(float lo, float hi) { unsigned r; asm volatile("v_cvt_pk_bf16_f32 %0, %1, %2" : "=v"(r) : "v"(lo), "v"(hi)); return r; }
__device__ __forceinline__ float bf_lo(unsigned w) { return __uint_as_float(w << 16); }
__device__ __forceinline__ float bf_hi(unsigned w) { return __uint_as_float(w & 0xffff0000u); }

template <int ACT  > struct EpiBf16 {
    static constexpr bool PERM = true;
    bf16_t* O; int ldc;
    __device__ __forceinline__ void operator()(const f32x4 (&acc)[2][2][4][2], const Unit& u, int wr, int wc, int fr, int fq) const {
        const int row0 = u.pm * BM + wr * 64 + fr, col0 = u.pn * BM + wc * 32 + 8 * fq;
#pragma unroll
        for (int ai = 0; ai < 2; ++ai)
#pragma unroll
            for (int m = 0; m < 4; ++m) { bf16_t* rowp = O + (size_t)(row0 + ai * HALF + m * 16) * ldc + col0;
#pragma unroll
                for (int bj = 0; bj < 2; ++bj) { f32x4 v0 = acc[ai][bj][m][0], v1 = acc[ai][bj][m][1];
                    if (ACT == 1) {
#pragma unroll
                        for (int e = 0; e < 4; ++e) { float a = fmaxf(v0[e], 0.f), b = fmaxf(v1[e], 0.f); v0[e] = a * a; v1[e] = b * b; } }
                    u32x4 w; w.x = cvt_pk_bf16(v0[0], v0[1]); w.y = cvt_pk_bf16(v0[2], v0[3]); w.z = cvt_pk_bf16(v1[0], v1[1]); w.w = cvt_pk_bf16(v1[2], v1[3]);
                    *(u32x4*)(rowp + bj * HALF) = w; } }
    }
};
struct EpiMerge {
    static constexpr bool PERM = true;
    const bf16_t* Y; const float* bg; bf16_t* Z;
    __device__ __forceinline__ void operator()(const f32x4 (&acc)[2][2][4][2], const Unit& u, int wr, int wc, int fr, int fq) const {
        const int row0 = u.pm * BM + wr * 64 + fr, dcol = u.pn * 64 + 16 * wc + 4 * fq;
        f32x4 bv[2][2];
#pragma unroll
        for (int bj = 0; bj < 2; ++bj)
#pragma unroll
            for (int n = 0; n < 2; ++n) bv[bj][n] = *(const f32x4*)(bg + (2 * bj + n) * 1024 + dcol);
#pragma unroll
        for (int ai = 0; ai < 2; ++ai)
#pragma unroll
            for (int m = 0; m < 4; ++m) { const size_t r = (size_t)(row0 + ai * HALF + m * 16);
                const bf16_t* yp = Y + r * 4096 + dcol;
                f32x4 z = (f32x4){0.f, 0.f, 0.f, 0.f};
#pragma unroll
                for (int bj = 0; bj < 2; ++bj)
#pragma unroll
                    for (int n = 0; n < 2; ++n) { const u32x2 yw = *(const u32x2*)(yp + (2 * bj + n) * 1024);
                        const f32x4 y = (f32x4){bf_lo(yw.x), bf_hi(yw.x), bf_lo(yw.y), bf_hi(yw.y)};
                        const f32x4 a = acc[ai][bj][m][n] + bv[bj][n];
#pragma unroll
                        for (int e = 0; e < 4; ++e) z[e] += __builtin_amdgcn_rcpf(1.f + __builtin_amdgcn_exp2f(a[e] * -1.4426950408889634f)) * y[e]; }
                u32x2 w; w.x = cvt_pk_bf16(z[0], z[1]); w.y = cvt_pk_bf16(z[2], z[3]);
                *(u32x2*)(Z + r * 1024 + dcol) = w; }
    }
};
template <bool BBF> struct EpiRes {
    static constexpr bool PERM = true;
    const void* base; bf16_t* out; int ldc;
    __device__ __forceinline__ void operator()(const f32x4 (&acc)[2][2][4][2], const Unit& u, int wr, int wc, int fr, int fq) const {
        const int row0 = u.pm * BM + wr * 64 + fr, col0 = u.pn * BM + wc * 32 + 8 * fq;
#pragma unroll
        for (int ai = 0; ai < 2; ++ai)
#pragma unroll
            for (int m = 0; m < 4; ++m) { const size_t off = (size_t)(row0 + ai * HALF + m * 16) * ldc + col0;
#pragma unroll
                for (int bj = 0; bj < 2; ++bj) { f32x4 b0, b1;
                    if (BBF) { const u32x4 w = *(const u32x4*)((const bf16_t*)base + off + bj * HALF);
                        b0 = (f32x4){bf_lo(w.x), bf_hi(w.x), bf_lo(w.y), bf_hi(w.y)}; b1 = (f32x4){bf_lo(w.z), bf_hi(w.z), bf_lo(w.w), bf_hi(w.w)}; }
                    else { const float* bp = (const float*)base + off + bj * HALF; b0 = *(const f32x4*)bp; b1 = *(const f32x4*)(bp + 4); }
                    const f32x4 v0 = b0 + acc[ai][bj][m][0], v1 = b1 + acc[ai][bj][m][1];
                    u32x4 w; w.x = cvt_pk_bf16(v0[0], v0[1]); w.y = cvt_pk_bf16(v0[2], v0[3]); w.z = cvt_pk_bf16(v1[0], v1[1]); w.w = cvt_pk_bf16(v1[2], v1[3]);
                    *(u32x4*)(out + off + bj * HALF) = w; } }
    }
};

template <class Epi, bool ALIGN_EPI>
__device__ __forceinline__ void gemm_phase(PG8_LAS unsigned char* lds, const Gemm g, const StaticOrder& S, const Epi& E) {
    int tid = threadIdx.x; asm volatile("" : "+v"(tid));
    const int wid = __builtin_amdgcn_readfirstlane(tid >> 6), lane = tid & 63, wr = wid >> 2, wc = wid & 3, fr = lane & 15, fq = lane >> 4;
    const int K = g.K, nt = K / BK;
    unsigned voffA[2], voffB[2];
#pragma unroll
    for (int i = 0; i < 2; ++i) { int R, C; stage_rc(tid * 16 + i * 8192, R, C); const int Rb = Epi::PERM ? ((R & ~31) + perm32(R & 31)) : R;
        voffA[i] = (unsigned)(R * g.lda + C) * 2u; voffB[i] = (unsigned)(Rb * g.ldb + C) * 2u; }
    const size_t kstep = (size_t)(BK * 2);
    const size_t hstepA = (size_t)HALF * g.lda * 2, hstepB = (size_t)HALF * g.ldb * 2;
    const size_t tstepA = 2 * hstepA, tstepB = 2 * hstepB;
    const unsigned ldsw = (unsigned)wid * 1024u;
    const int aoff = lds_byte(wr * 64 + fr, fq * 8), boff = lds_byte(wc * 32 + fr, fq * 8);
#define PG8_SA(b, h) (((b) * 2 + (h)) * HTB)
#define PG8_SB(b, h) ((4 + (b) * 2 + (h)) * HTB)
#define PG8_STAGE(bufoff, gbase, voff) do { _Pragma("unroll") for (int _i = 0; _i < 2; ++_i) \
        __builtin_amdgcn_global_load_lds((const unsigned*)((const char*)(gbase) + (voff)[_i]), (PG8_LAS unsigned*)(lds + (bufoff) + ldsw + _i * 8192), 16, 0, 0); } while (0)
#define PG8_LDA(dst, b, h) do { _Pragma("unroll") for (int m = 0; m < 4; ++m) _Pragma("unroll") for (int k = 0; k < 2; ++k) dst[m][k] = *(const PG8_LAS bf16x8*)(lds + PG8_SA(b, h) + aoff + m * 2048 + k * 1024); } while (0)
#define PG8_LDB(dst, b, h) do { _Pragma("unroll") for (int n = 0; n < 2; ++n) _Pragma("unroll") for (int k = 0; k < 2; ++k) dst[n][k] = *(const PG8_LAS bf16x8*)(lds + PG8_SB(b, h) + boff + n * 2048 + k * 1024); } while (0)
#define PG8_MMA(ai, bj, At, Bt) do { __builtin_amdgcn_s_setprio(1); _Pragma("unroll") for (int m = 0; m < 4; ++m) _Pragma("unroll") for (int n = 0; n < 2; ++n) _Pragma("unroll") for (int k = 0; k < 2; ++k) \
        acc[ai][bj][m][n] = __builtin_amdgcn_mfma_f32_16x16x32_bf16(Bt[n][k], At[m][k], acc[ai][bj][m][n], 0, 0, 0); __builtin_amdgcn_s_setprio(0); } while (0)
#define PG8_WAIT_V(n) asm volatile("s_waitcnt vmcnt(" #n ")" ::: "memory")
#define PG8_WAIT_L(n) asm volatile("s_waitcnt lgkmcnt(" #n ")" ::: "memory")
#define PG8_BAR __builtin_amdgcn_s_barrier()
#define PG8_SCHED __builtin_amdgcn_sched_barrier(0)
#define PG8_APTR(uu) ((const char*)g.A + (size_t)(uu).pm * tstepA + (size_t)((uu).pn >> g.a_shift) * (size_t)g.a_zoff * 2)
    Unit cur, nxt; int ui = 0;
    if (!S.next(0, cur)) return;
    f32x4 acc[2][2][4][2];
#pragma unroll
    for (int a = 0; a < 2; ++a)
#pragma unroll
        for (int b = 0; b < 2; ++b)
#pragma unroll
            for (int m = 0; m < 4; ++m)
#pragma unroll
                for (int n = 0; n < 2; ++n) acc[a][b][m][n] = (f32x4){0.f, 0.f, 0.f, 0.f};
    bf16x8 At[4][2], B0[2][2], B1[2][2];
    const char* cA = PG8_APTR(cur); const char* cB = (const char*)g.Bt + (size_t)cur.pn * tstepB;
    PG8_STAGE(PG8_SB(0, 0), cB, voffB); PG8_STAGE(PG8_SB(0, 1), cB + hstepB, voffB); PG8_STAGE(PG8_SA(0, 0), cA, voffA); PG8_STAGE(PG8_SA(0, 1), cA + hstepA, voffA);
    if (wr == 1) PG8_BAR;
    PG8_WAIT_V(2); PG8_BAR;
    PG8_STAGE(PG8_SB(1, 0), cB + kstep, voffB); PG8_STAGE(PG8_SA(1, 0), cA + kstep, voffA); PG8_STAGE(PG8_SB(1, 1), cB + hstepB + kstep, voffB);
    PG8_WAIT_V(6); PG8_BAR;
    for (;;) {
        const bool has_next = S.next(ui + 1, nxt);
        const char* nA = has_next ? PG8_APTR(nxt) : cA; const char* nB = has_next ? (const char*)g.Bt + (size_t)nxt.pn * tstepB : cB;
        for (int t = 0; t < nt; t += 2) {
            const bool last = (t == nt - 2);
            const char* a1 = cA + (size_t)(t + 1) * kstep;
            const char* a2 = last ? nA : cA + (size_t)(t + 2) * kstep; const char* b2 = last ? nB : cB + (size_t)(t + 2) * kstep;
            const char* a3 = a2 + kstep; const char* b3 = b2 + kstep;
            PG8_LDB(B0, 0, 0); PG8_LDB(B1, 0, 1); PG8_SCHED; PG8_LDA(At, 0, 0); PG8_STAGE(PG8_SA(1, 1), a1 + hstepA, voffA);
            PG8_WAIT_V(8); PG8_WAIT_L(0); PG8_BAR; PG8_MMA(0, 0, At, B0); PG8_MMA(0, 1, At, B1); PG8_BAR; PG8_SCHED;
            PG8_LDA(At, 0, 1); PG8_STAGE(PG8_SB(0, 0), b2, voffB); PG8_STAGE(PG8_SB(0, 1), b2 + hstepB, voffB); PG8_STAGE(PG8_SA(0, 0), a2, voffA);
            PG8_WAIT_V(8); PG8_WAIT_L(0); PG8_BAR; PG8_MMA(1, 0, At, B0); PG8_MMA(1, 1, At, B1); PG8_BAR; PG8_SCHED;
            PG8_LDB(B0, 1, 0); PG8_LDB(B1, 1, 1); PG8_SCHED; PG8_LDA(At, 1, 0); PG8_STAGE(PG8_SA(0, 1), a2 + hstepA, voffA);
            PG8_WAIT_V(8); PG8_WAIT_L(0); PG8_BAR; PG8_MMA(0, 0, At, B0); PG8_MMA(0, 1, At, B1); PG8_BAR; PG8_SCHED;
            PG8_LDA(At, 1, 1); PG8_STAGE(PG8_SB(1, 0), b3, voffB); PG8_STAGE(PG8_SB(1, 1), b3 + hstepB, voffB); PG8_STAGE(PG8_SA(1, 0), a3, voffA);
            PG8_WAIT_V(8); PG8_WAIT_L(0); PG8_BAR; PG8_MMA(1, 0, At, B0); PG8_MMA(1, 1, At, B1); PG8_BAR; PG8_SCHED;
        }
        if constexpr (ALIGN_EPI) { if (wr == 0) PG8_BAR; }
        E(acc, cur, wr, wc, fr, fq);
        if (!has_next) break;
#pragma unroll
        for (int a = 0; a < 2; ++a)
#pragma unroll
            for (int b = 0; b < 2; ++b)
#pragma unroll
                for (int m = 0; m < 4; ++m)
#pragma unroll
                    for (int n = 0; n < 2; ++n) acc[a][b][m][n] = (f32x4){0.f, 0.f, 0.f, 0.f};
        cur = nxt; cA = nA; cB = nB; ++ui;
        if constexpr (ALIGN_EPI) { if (wr == 1) PG8_BAR; }
    }
    PG8_WAIT_V(0);
    if constexpr (!ALIGN_EPI) { if (wr == 0) PG8_BAR; }
    PG8_BAR;
#undef PG8_SA
#undef PG8_SB
#undef PG8_STAGE
#undef PG8_LDA
#undef PG8_LDB
#undef PG8_MMA
#undef PG8_WAIT_V
#undef PG8_WAIT_L
#undef PG8_BAR
#undef PG8_SCHED
#undef PG8_APTR
}
}

namespace att {
typedef unsigned short bf16_t;
typedef short bf16x8 __attribute__((ext_vector_type(8)));
typedef short s16x4 __attribute__((ext_vector_type(4)));
typedef float f32x16 __attribute__((ext_vector_type(16)));
typedef float f32x4 __attribute__((ext_vector_type(4)));
typedef unsigned u32x4 __attribute__((ext_vector_type(4)));
typedef unsigned u32x2 __attribute__((ext_vector_type(2)));
constexpr int SHM_V = 8192, SHM_K = 16384;
constexpr int OFF_V = 0, OFF_K = 2 * SHM_V, OFF_WS = OFF_K + 2 * SHM_K, OFF_TAB = OFF_WS + 2048, LDS_BYTES = OFF_TAB + 2048;
constexpr float LOG2E = 1.4426950408889634f;
constexpr float THR2 = 8.f * LOG2E;
#define SBAR() __builtin_amdgcn_sched_barrier(0)
__device__ __forceinline__ int crow(int r, int hi) { return (r & 3) + 8 * (r >> 2) + 4 * hi; }
__device__ __forceinline__ unsigned cvtpk(float lo, float hi) { unsigned r; asm volatile("v_cvt_pk_bf16_f32 %0, %1, %2" : "=v"(r) : "v"(lo), "v"(hi)); return r; }
__device__ __forceinline__ float bf_lo(unsigned w) { return __uint_as_float(w << 16); }
__device__ __forceinline__ float bf_hi(unsigned w) { return __uint_as_float(w & 0xffff0000u); }

struct UnitP {
    const bf16_t* Q; const bf16_t* K; const bf16_t* V; bf16_t* O;
    const bf16_t* K2;
    int ldq, ldk, ldv, ldo;
    int t_lo, nt;
    int q0;
    float cscale;
    float slope2, sink2;
    const float* cosT; const float* sinT;
};

template <int DQK> __device__ __forceinline__ int kaddr(int row, int chunk) {
    if (DQK == 64) return row * 128 + ((chunk ^ ((row >> 1) & 7)) << 4);
    else return row * 256 + ((chunk ^ (row & 15)) << 4);
}
__device__ __forceinline__ int v_st(int k, int c) { const int kk = (k & ~0xC) | ((k & 4) << 1) | ((k & 8) >> 1); return ((kk >> 3) * 2 + (c >> 5)) * 512 + ((kk & 7) * 32 + (c & 31)) * 2; }
__device__ __forceinline__ int v_rd_base(int lane) { return ((lane & 3) << 3) | (((lane >> 2) & 3) << 6) | (((lane >> 4) & 1) << 5) | (((lane >> 5) & 1) << 8); }
constexpr int v_rd_off(int d0, int ks, int half) { return d0 * 512 + ks * 2048 + half * 1024; }
template <int OFF> __device__ __forceinline__ s16x4 tr_read(int vb) { s16x4 r; asm volatile("ds_read_b64_tr_b16 %0, %1 offset:%2" : "=&v"(r) : "v"(vb), "i"(OFF) : "memory"); return r; }
template <int D0> __device__ __forceinline__ void pv_one(f32x16& od, int vb, bf16x8 pa0, bf16x8 pa1, bf16x8 pa2, bf16x8 pa3) {
    const s16x4 l0 = tr_read<v_rd_off(D0, 0, 0)>(vb), h0 = tr_read<v_rd_off(D0, 0, 1)>(vb), l1 = tr_read<v_rd_off(D0, 1, 0)>(vb), h1 = tr_read<v_rd_off(D0, 1, 1)>(vb);
    const s16x4 l2 = tr_read<v_rd_off(D0, 2, 0)>(vb), h2 = tr_read<v_rd_off(D0, 2, 1)>(vb), l3 = tr_read<v_rd_off(D0, 3, 0)>(vb), h3 = tr_read<v_rd_off(D0, 3, 1)>(vb);
    asm volatile("s_waitcnt lgkmcnt(0)" ::: "memory"); SBAR();
#define PK(L, H) (bf16x8){L[0], L[1], L[2], L[3], H[0], H[1], H[2], H[3]}
    od = __builtin_amdgcn_mfma_f32_32x32x16_bf16(pa0, PK(l0, h0), od, 0, 0, 0);
    od = __builtin_amdgcn_mfma_f32_32x32x16_bf16(pa1, PK(l1, h1), od, 0, 0, 0);
    od = __builtin_amdgcn_mfma_f32_32x32x16_bf16(pa2, PK(l2, h2), od, 0, 0, 0);
    od = __builtin_amdgcn_mfma_f32_32x32x16_bf16(pa3, PK(l3, h3), od, 0, 0, 0);
#undef PK
}
__device__ __forceinline__ void partialSM(f32x16& p0, f32x16& p1, float& m_reg, float& alpha) {
    float pmax = p0[0];
#pragma unroll
    for (int r = 1; r < 16; ++r) pmax = fmaxf(pmax, p0[r]);
#pragma unroll
    for (int r = 0; r < 16; ++r) pmax = fmaxf(pmax, p1[r]);
    { auto rr = __builtin_amdgcn_permlane32_swap(__float_as_uint(pmax), __float_as_uint(pmax), false, false);
      pmax = fmaxf(__uint_as_float(rr[0]), __uint_as_float(rr[1])); }
    float mn;
    if (__builtin_expect(__all(pmax - m_reg <= THR2), 1)) { mn = m_reg; alpha = 1.f; }
    else { mn = fmaxf(m_reg, pmax); alpha = __builtin_amdgcn_exp2f(m_reg - mn); m_reg = mn; }
#pragma unroll
    for (int r = 0; r < 16; ++r) p0[r] = p0[r] - mn;
#pragma unroll
    for (int r = 0; r < 16; ++r) p1[r] = p1[r] - mn;
#pragma unroll
    for (int r = 0; r < 16; ++r) p0[r] = __builtin_amdgcn_exp2f(p0[r]);
}
__device__ __forceinline__ void finishSM(f32x16& p0, f32x16& p1, float alpha, float& l_reg, bf16x8& pa0, bf16x8& pa1, bf16x8& pa2, bf16x8& pa3) {
#pragma unroll
    for (int r = 0; r < 16; ++r) p1[r] = __builtin_amdgcn_exp2f(p1[r]);
    float ps = 0;
#pragma unroll
    for (int r = 0; r < 16; ++r) ps += p0[r];
#pragma unroll
    for (int r = 0; r < 16; ++r) ps += p1[r];
    { auto rr = __builtin_amdgcn_permlane32_swap(__float_as_uint(ps), __float_as_uint(ps), false, false);
      ps = __uint_as_float(rr[0]) + __uint_as_float(rr[1]); }
    l_reg = l_reg * alpha + ps;
#define PK4(P, BASE, OUT) do { unsigned a0 = cvtpk(P[BASE + 0], P[BASE + 1]), a1 = cvtpk(P[BASE + 2], P[BASE + 3]);   \
    unsigned b0 = cvtpk(P[BASE + 4], P[BASE + 5]), b1 = cvtpk(P[BASE + 6], P[BASE + 7]);                              \
    auto r0 = __builtin_amdgcn_permlane32_swap(a0, b0, false, false); auto r1 = __builtin_amdgcn_permlane32_swap(a1, b1, false, false); \
    u32x4 w = {r0[0], r1[0], r0[1], r1[1]}; OUT = *reinterpret_cast<bf16x8*>(&w); } while (0)
    PK4(p0, 0, pa0); PK4(p0, 8, pa1); PK4(p1, 0, pa2); PK4(p1, 8, pa3);
#undef PK4
}
__device__ __forceinline__ float rowmax32(const f32x16& p0, const f32x16& p1) {
    float pmax = p0[0];
#pragma unroll
    for (int r = 1; r < 16; ++r) pmax = fmaxf(pmax, p0[r]);
#pragma unroll
    for (int r = 0; r < 16; ++r) pmax = fmaxf(pmax, p1[r]);
    auto rr = __builtin_amdgcn_permlane32_swap(__float_as_uint(pmax), __float_as_uint(pmax), false, false);
    return fmaxf(__uint_as_float(rr[0]), __uint_as_float(rr[1]));
}
template <bool FIRST> __device__ __forceinline__ void partialSM_fast(f32x16& p0, f32x16& p1, float& m_reg, f32x16& negm, float& alpha) {
    const float pmax = rowmax32(p0, p1);
    if (!FIRST && __builtin_expect(__all(pmax <= THR2), 1)) { alpha = 1.f; }
    else { const float dl = FIRST ? pmax : fmaxf(pmax, 0.f); m_reg += dl;
#pragma unroll
        for (int r = 0; r < 16; ++r) { p0[r] -= dl; p1[r] -= dl; }
#pragma unroll
        for (int r = 0; r < 16; ++r) negm[r] = -m_reg;
        alpha = __builtin_amdgcn_exp2f(-dl); }
#pragma unroll
    for (int r = 0; r < 16; ++r) p0[r] = __builtin_amdgcn_exp2f(p0[r]);
}
__device__ __forceinline__ void finishSM_fast(f32x16& p0, f32x16& p1, bf16x8& pa0, bf16x8& pa1, bf16x8& pa2, bf16x8& pa3) {
#pragma unroll
    for (int r = 0; r < 16; ++r) p1[r] = __builtin_amdgcn_exp2f(p1[r]);
#define PK4(P, BASE, OUT) do { unsigned a0 = cvtpk(P[BASE + 0], P[BASE + 1]), a1 = cvtpk(P[BASE + 2], P[BASE + 3]);   \
    unsigned b0 = cvtpk(P[BASE + 4], P[BASE + 5]), b1 = cvtpk(P[BASE + 6], P[BASE + 7]);                              \
    auto r0 = __builtin_amdgcn_permlane32_swap(a0, b0, false, false); auto r1 = __builtin_amdgcn_permlane32_swap(a1, b1, false, false); \
    u32x4 w = {r0[0], r1[0], r0[1], r1[1]}; OUT = *reinterpret_cast<bf16x8*>(&w); } while (0)
    PK4(p0, 0, pa0); PK4(p0, 8, pa1); PK4(p1, 0, pa2); PK4(p1, 8, pa3);
#undef PK4
}
__device__ __forceinline__ void pv_ones(f32x16& ol, bf16x8 pa0, bf16x8 pa1, bf16x8 pa2, bf16x8 pa3) {
    const bf16x8 ones = {0x3F80, 0x3F80, 0x3F80, 0x3F80, 0x3F80, 0x3F80, 0x3F80, 0x3F80};
    ol = __builtin_amdgcn_mfma_f32_32x32x16_bf16(pa0, ones, ol, 0, 0, 0);
    ol = __builtin_amdgcn_mfma_f32_32x32x16_bf16(pa1, ones, ol, 0, 0, 0);
    ol = __builtin_amdgcn_mfma_f32_32x32x16_bf16(pa2, ones, ol, 0, 0, 0);
    ol = __builtin_amdgcn_mfma_f32_32x32x16_bf16(pa3, ones, ol, 0, 0, 0);
}
template <int DQK> __device__ __forceinline__ void qkt_neg(f32x16& p0, f32x16& p1, const char* Ks, const bf16x8* qr, const f32x16& negm, int r32, int hi) {
#pragma unroll
    for (int d0 = 0; d0 < DQK / 16; ++d0) {
        const int a0 = kaddr<DQK>(r32, d0 * 2 + hi);
        const bf16x8 b0 = *reinterpret_cast<const bf16x8*>(Ks + a0);
        const bf16x8 b1 = *reinterpret_cast<const bf16x8*>(Ks + a0 + 32 * (DQK == 64 ? 128 : 256));
        if (d0 == 0) { p0 = __builtin_amdgcn_mfma_f32_32x32x16_bf16(b0, qr[0], negm, 0, 0, 0); p1 = __builtin_amdgcn_mfma_f32_32x32x16_bf16(b1, qr[0], negm, 0, 0, 0); }
        else { p0 = __builtin_amdgcn_mfma_f32_32x32x16_bf16(b0, qr[d0], p0, 0, 0, 0); p1 = __builtin_amdgcn_mfma_f32_32x32x16_bf16(b1, qr[d0], p1, 0, 0, 0); } }
}
template <int DQK> __device__ __forceinline__ void qkt(f32x16& p0, f32x16& p1, const char* Ks, const bf16x8* qr, int r32, int hi) {
    p0 = f32x16{}; p1 = f32x16{};
#pragma unroll
    for (int d0 = 0; d0 < DQK / 16; ++d0) {
        const int a0 = kaddr<DQK>(r32, d0 * 2 + hi);
        const bf16x8 b0 = *reinterpret_cast<const bf16x8*>(Ks + a0);
        const bf16x8 b1 = *reinterpret_cast<const bf16x8*>(Ks + a0 + 32 * (DQK == 64 ? 128 : 256));
        p0 = __builtin_amdgcn_mfma_f32_32x32x16_bf16(b0, qr[d0], p0, 0, 0, 0);
        p1 = __builtin_amdgcn_mfma_f32_32x32x16_bf16(b1, qr[d0], p1, 0, 0, 0); }
}
template <int MODE> __device__ __forceinline__ void score_fix(f32x16& p0, f32x16& p1, const UnitP& P, int tt, int wid, int r32, int hi, const float* tab) {
    const float NEG = -INFINITY;
    if (MODE == 2) {
        const int r = (P.q0 >> 6) + (wid >> 1); int c = (wid & 1) * 32 + r32; asm volatile("" : "+v"(c));
        int rs = r - 4; rs = rs < 0 ? 0 : (rs > 248 ? 248 : rs);
        int cs = c - 8; cs = cs < 0 ? 0 : (cs > 48 ? 48 : cs);
        const int kr = tt;
        if (kr < rs || kr > rs + 7) {
#pragma unroll
            for (int x = 0; x < 16; ++x) { p0[x] = NEG; p1[x] = NEG; }
        } else {
            const int ib = (kr - r + 7) * 31 + 15 - c + 4 * hi, wlo = cs - 4 * hi;
#pragma unroll
            for (int x = 0; x < 16; ++x) {
                const int kq = (x & 3) + 8 * (x >> 2);
                const int i0 = ((unsigned)(kq - wlo) < 16u) ? (ib + kq) : 465, i1 = ((unsigned)(kq + 32 - wlo) < 16u) ? (ib + kq + 32) : 465;
                p0[x] = fmaf(p0[x], P.cscale, tab[i0]); p1[x] = fmaf(p1[x], P.cscale, tab[i1]); }
        }
    } else if (MODE == 3) {
        int qpos = P.q0 + wid * 32 + r32; asm volatile("" : "+v"(qpos));
        const int kb = tt * 64, qw = P.q0 + wid * 32;
        if (kb > qw + 31 + 128 || kb + 63 < qw - 128) {
#pragma unroll
            for (int x = 0; x < 16; ++x) { p0[x] = NEG; p1[x] = NEG; }
        } else {
            const float qf = (float)(qpos - kb - 4 * hi), ns = -P.slope2;
#pragma unroll
            for (int x = 0; x < 16; ++x) {
                const float d0 = qf - (float)((x & 3) + 8 * (x >> 2)), d1 = d0 - 32.f;
                const float a0 = fabsf(d0), a1 = fabsf(d1);
                const float v0 = fmaf(a0, ns, p0[x] * P.cscale), v1 = fmaf(a1, ns, p1[x] * P.cscale);
                p0[x] = a0 <= 128.f ? v0 : NEG; p1[x] = a1 <= 128.f ? v1 : NEG; }
        }
    }
}

template <int MODE, bool NM = false>
__device__ __forceinline__ void attn_unit(const UnitP& P, char* lds) {
    constexpr int DQK = (MODE == 1) ? 96 : 64, NQ = DQK / 16, KP = (DQK == 64) ? 128 : 256;
    int tid = threadIdx.x; asm volatile("" : "+v"(tid));
    const int wid = __builtin_amdgcn_readfirstlane(tid >> 6), lane = tid & 63, r32 = lane & 31, hi = lane >> 5;
    char* V_lds = lds + OFF_V; char* K_lds = lds + OFF_K;
    float* ws = (float*)(lds + OFF_WS) + wid * 64; float* li_l = ws; float* al_l = ws + 32;
    const float* tab = (const float*)(lds + OFF_TAB);
    float m_reg = -1e30f, l_reg = 0; f32x16 o[2] = {}; bf16x8 qr[NQ];
    const bf16_t* Qw = P.Q + (size_t)(wid * 32 + r32) * P.ldq + hi * 8;
#pragma unroll
    for (int d0 = 0; d0 < NQ; ++d0) qr[d0] = *reinterpret_cast<const bf16x8*>(Qw + d0 * 16);
    if (MODE == 1) {
        const int pos = P.q0 + wid * 32 + r32;
        const f32x4 c0 = *(const f32x4*)(P.cosT + pos * 16 + hi * 8), c1 = *(const f32x4*)(P.cosT + pos * 16 + hi * 8 + 4);
        const f32x4 s0 = *(const f32x4*)(P.sinT + pos * 16 + hi * 8), s1 = *(const f32x4*)(P.sinT + pos * 16 + hi * 8 + 4);
        const float cc[8] = {c0[0], c0[1], c0[2], c0[3], c1[0], c1[1], c1[2], c1[3]}, ss[8] = {s0[0], s0[1], s0[2], s0[3], s1[0], s1[1], s1[2], s1[3]};
        const float sc = P.cscale;
#pragma unroll
        for (int d0 = 0; d0 < 4; ++d0) { u32x4 w = *reinterpret_cast<u32x4*>(&qr[d0]);
#pragma unroll
            for (int e = 0; e < 4; ++e) w[e] = cvtpk(bf_lo(w[e]) * sc, bf_hi(w[e]) * sc);
            qr[d0] = *reinterpret_cast<bf16x8*>(&w); }
        u32x4 w1 = *reinterpret_cast<u32x4*>(&qr[4]), w2 = *reinterpret_cast<u32x4*>(&qr[5]);
#pragma unroll
        for (int e = 0; e < 4; ++e) {
            const float x1a = bf_lo(w1[e]), x1b = bf_hi(w1[e]), x2a = bf_lo(w2[e]), x2b = bf_hi(w2[e]);
            const float ca = cc[2 * e], cb = cc[2 * e + 1], sa = ss[2 * e], sb = ss[2 * e + 1];
            w1[e] = cvtpk((x1a * ca - x2a * sa) * sc, (x1b * cb - x2b * sb) * sc);
            w2[e] = cvtpk((x2a * ca + x1a * sa) * sc, (x2b * cb + x1b * sb) * sc); }
        qr[4] = *reinterpret_cast<bf16x8*>(&w1); qr[5] = *reinterpret_cast<bf16x8*>(&w2);
    }
    const int srow = tid >> 3, sch = tid & 7;
    const int kst0 = kaddr<DQK>(srow, sch), kst1 = kaddr<DQK>(srow, 8 + (sch >> 1)) + (sch & 1) * 8, vst = v_st(srow, sch * 8);
    const int vb0 = (int)(uintptr_t)V_lds + v_rd_base(lane);
    const bf16_t* Kg = P.K + (size_t)srow * P.ldk + sch * 8;
    const bf16_t* Kg2 = P.K2 + (size_t)srow * 32 + sch * 4;
    const bf16_t* Vg = P.V + (size_t)srow * P.ldv + sch * 8;
    struct { u32x4 k0; u32x2 k1; u32x4 v; } sr_[2];
#define SLOAD(i, tile) do { const size_t _k = (size_t)(tile) * 64; sr_[i].k0 = *(const u32x4*)(Kg + _k * P.ldk); if (DQK == 96) sr_[i].k1 = *(const u32x2*)(Kg2 + _k * 32); \
    sr_[i].v = *(const u32x4*)(Vg + _k * P.ldv); } while (0)
#define SWRITE(b, i) do { *(u32x4*)(K_lds + (b) * SHM_K + kst0) = sr_[i].k0; if (DQK == 96) *(u32x2*)(K_lds + (b) * SHM_K + kst1) = sr_[i].k1; \
    *(u32x4*)(V_lds + (b) * SHM_V + vst) = sr_[i].v; } while (0)
#define SWAIT() do { if (DQK == 96) asm volatile("s_waitcnt vmcnt(3)" ::: "memory"); else asm volatile("s_waitcnt vmcnt(2)" ::: "memory"); } while (0)
#define RESC(a) do { if (__any((a) < 1.f)) { if (hi == 0) al_l[r32] = (a); asm volatile("s_waitcnt lgkmcnt(0)" ::: "memory"); \
    _Pragma("unroll") for (int d = 0; d < 2; ++d) _Pragma("unroll") for (int r = 0; r < 16; ++r) o[d][r] *= al_l[crow(r, hi)]; } } while (0)
#define FIX(p0, p1, tt) do { if (MODE >= 2) score_fix<MODE>(p0, p1, P, (tt), wid, r32, hi, tab); } while (0)
    f32x16 pA0, pA1, pB0, pB1; float alA, alB; bf16x8 pa0, pa1, pa2, pa3; const int NT = P.nt, T0 = P.t_lo;
    constexpr int SE = 0, SO = 1;
    constexpr bool FAST = (MODE < 2);
    f32x16 negm = {}; f32x16 ol = {};
    if (FAST) { m_reg = 0.f; asm volatile("" : "+v"(negm)); }
#define QKT(p0, p1, kb, tt) do { if (FAST) qkt_neg<DQK>(p0, p1, (kb), qr, negm, r32, hi); else { qkt<DQK>(p0, p1, (kb), qr, r32, hi); FIX(p0, p1, (tt)); } } while (0)
#define PSM(p0, p1, al) do { if (NM) { _Pragma("unroll") for (int r_ = 0; r_ < 16; ++r_) p0[r_] = __builtin_amdgcn_exp2f(p0[r_]); } else if (FAST) partialSM_fast<false>(p0, p1, m_reg, negm, al); else partialSM(p0, p1, m_reg, al); } while (0)
#define FSM(p0, p1, al) do { if (FAST) finishSM_fast(p0, p1, pa0, pa1, pa2, pa3); else finishSM(p0, p1, al, l_reg, pa0, pa1, pa2, pa3); } while (0)
#define PVT(vb) do { pv_one<0>(o[0], (vb), pa0, pa1, pa2, pa3); pv_one<1>(o[1], (vb), pa0, pa1, pa2, pa3); if (FAST) pv_ones(ol, pa0, pa1, pa2, pa3); } while (0)
#define RESC2(a) do { if (!NM && __any((a) < 1.f)) { if (hi == 0) al_l[r32] = (a); asm volatile("s_waitcnt lgkmcnt(0)" ::: "memory"); \
    _Pragma("unroll") for (int r = 0; r < 16; ++r) { const float f_ = al_l[crow(r, hi)]; o[0][r] *= f_; o[1][r] *= f_; if (FAST) ol[r] *= f_; } } } while (0)
    SLOAD(SE, T0); asm volatile("s_waitcnt vmcnt(0)" ::: "memory"); SWRITE(0, SE); __syncthreads();
    if (NM) { qkt_neg<DQK>(pA0, pA1, K_lds, qr, negm, r32, hi); PSM(pA0, pA1, alA); }
    else if (FAST) { qkt_neg<DQK>(pA0, pA1, K_lds, qr, negm, r32, hi); partialSM_fast<true>(pA0, pA1, m_reg, negm, alA); }
    else { qkt<DQK>(pA0, pA1, K_lds, qr, r32, hi); FIX(pA0, pA1, T0); partialSM(pA0, pA1, m_reg, alA); }
    SLOAD(SO, T0 + 1); if (2 < NT) SLOAD(SE, T0 + 2);
    SWAIT(); SWRITE(1, SO); __syncthreads();
    for (int j = 1; j + 1 < NT; j += 2) {
        SBAR(); QKT(pB0, pB1, K_lds + SHM_K, T0 + j);
        FSM(pA0, pA1, alA); SBAR();
        SLOAD(SO, T0 + j + 2); SBAR();
        PVT(vb0); PSM(pB0, pB1, alB);
        __syncthreads(); SWAIT(); SWRITE(0, SE);
        RESC2(alB); __syncthreads();
        SBAR(); QKT(pA0, pA1, K_lds, T0 + j + 1);
        FSM(pB0, pB1, alB); SBAR();
        if (j + 3 < NT) SLOAD(SE, T0 + j + 3); SBAR();
        PVT(vb0 + SHM_V); PSM(pA0, pA1, alA);
        __syncthreads(); SWAIT(); SWRITE(1, SO);
        RESC2(alA); __syncthreads();
    }
    SBAR(); QKT(pB0, pB1, K_lds + SHM_K, T0 + NT - 1);
    FSM(pA0, pA1, alA); SBAR();
    PVT(vb0); PSM(pB0, pB1, alB);
    __syncthreads(); RESC2(alB);
    FSM(pB0, pB1, alB); SBAR();
    PVT(vb0 + SHM_V);
    float rli[16];
    if (FAST) {
#pragma unroll
        for (int r = 0; r < 16; ++r) rli[r] = __builtin_amdgcn_rcpf(ol[r]);
    } else {
        if (MODE == 3) l_reg += __builtin_amdgcn_exp2f(P.sink2 - m_reg);
        if (hi == 0) li_l[r32] = l_reg; asm volatile("s_waitcnt lgkmcnt(0)" ::: "memory");
#pragma unroll
        for (int r = 0; r < 16; ++r) rli[r] = __builtin_amdgcn_rcpf(li_l[crow(r, hi)]);
    }
    bf16_t* Ow = P.O + (size_t)(wid * 32) * P.ldo;
#pragma unroll
    for (int r = 0; r < 16; ++r) { const int orow = crow(r, hi);
#pragma unroll
        for (int d0 = 0; d0 < 2; ++d0) { const unsigned w = cvtpk(o[d0][r] * rli[r], 0.f); Ow[(size_t)orow * P.ldo + d0 * 32 + r32] = (bf16_t)(w & 0xffffu); } }
#undef QKT
#undef PSM
#undef FSM
#undef PVT
#undef RESC2
    __syncthreads();
#undef SLOAD
#undef SWRITE
#undef SWAIT
#undef RESC
#undef FIX
}
#undef SBAR
}

typedef unsigned short bf16;
typedef float f32x4 __attribute__((ext_vector_type(4)));
typedef unsigned u32x4 __attribute__((ext_vector_type(4)));
typedef unsigned u32x2 __attribute__((ext_vector_type(2)));
#define LAS __attribute__((address_space(3)))

constexpr int T_TOK = 32768, SEQ = 16384, DM = 1024, FF = 4096, INW = 2144, INWP = 2304, DEPTH = 2;
constexpr float EPS = 1e-6f;
constexpr size_t MiB = 1u << 20;
constexpr size_t WS_COS = 1 * MiB, WS_SIN = 2 * MiB, WS_W = 4 * MiB, W_LAYER = 34 * MiB;
constexpr size_t WO_IN = 0, WO_G = WO_IN + (size_t)INWP * 1024 * 2, WO_D = WO_G + (size_t)4096 * 1024 * 2, WO_B = WO_D + (size_t)1024 * 384 * 2,
                 WO_O = WO_B + (size_t)4096 * 256 * 2, WO_1 = WO_O + (size_t)1024 * 1024 * 2, WO_2 = WO_1 + (size_t)4096 * 1024 * 2, WO_END = WO_2 + (size_t)4096 * 1024 * 2;
static_assert(WO_END <= W_LAYER, "weight map");
constexpr size_t WS_H = 72 * MiB, WS_BR = 136 * MiB, WS_BIG = 200 * MiB, WS_END = 456 * MiB;
constexpr size_t BIG_QKV = 0, BIG_DA = 144 * MiB, BIG_DX = 168 * MiB, BIG_KR = 232 * MiB;
constexpr int LDS_TOTAL = 147456;

#ifndef EN_MASK
#define EN_MASK 0xffff
#endif
#define EN(k) ((EN_MASK >> (k)) & 1)
#ifndef ATT_MASK
#define ATT_MASK 0xf
#endif
#define AEN(k) ((ATT_MASK >> (k)) & 1)
struct Params { const float* in[19]; float* out; unsigned char* ws; int ph_lo, ph_hi; };
constexpr int PAR_OFF = 139264;
__device__ __forceinline__ unsigned long long par_get(LAS unsigned char* lds, int i) {
    volatile LAS unsigned* pp = (volatile LAS unsigned*)(lds + PAR_OFF) + 2 * i;
    const unsigned lo = __builtin_amdgcn_readfirstlane(pp[0]), hi = __builtin_amdgcn_readfirstlane(pp[1]);
    return ((unsigned long long)hi << 32) | lo;
}
#define PIN(i) (kp.in[(i)])
#define PWS() (kp.ws)
#define POUT() (kp.out)

__device__ __forceinline__ unsigned f2bf(float f) { unsigned u = __builtin_bit_cast(unsigned, f); return (u + 0x7fffu + ((u >> 16) & 1u)) >> 16; }
__device__ __forceinline__ unsigned pk2(float lo, float hi) { return f2bf(lo) | (f2bf(hi) << 16); }
__device__ __forceinline__ float bflo(unsigned w) { return __uint_as_float(w << 16); }
__device__ __forceinline__ float bfhi(unsigned w) { return __uint_as_float(w & 0xffff0000u); }
__device__ __forceinline__ float wave_sum(float v) {
#pragma unroll
    for (int o = 1; o < 64; o <<= 1) v += __shfl_xor(v, o);
    return v;
}


#define XB_TMO      128
#define XB_XCNT(j)  (256  + 64 * (j))
#define XB_XSUB(j)  (1280 + 64 * (j))
#define XB_XGEN(j)  (2304 + 64 * (j))
#define XB_TOP      3328
#define XB_TOPGEN   3392
#define XCD_BAR_WORDS 3456
#define XB_SPIN_CAP (1u << 18)
__device__ __forceinline__ unsigned xb_ld(unsigned* p)              { return __hip_atomic_load(p, __ATOMIC_RELAXED, __HIP_MEMORY_SCOPE_AGENT); }
__device__ __forceinline__ unsigned xb_add(unsigned* p, unsigned v) { return __hip_atomic_fetch_add(p, v, __ATOMIC_RELAXED, __HIP_MEMORY_SCOPE_AGENT); }
__device__ __forceinline__ unsigned xb_xcc_id() { return (unsigned)__builtin_amdgcn_s_getreg((3 << 11) | 20) & 0xFu; }
#define XB_SPIN(cond, bar) do { unsigned _sp = 0; while (cond) { __builtin_amdgcn_s_sleep(1); \
    if ((++_sp & 255u) == 0u) { if (xb_ld(&(bar)[XB_TMO])) break; if (_sp > XB_SPIN_CAP) { atomicAdd(&(bar)[XB_TMO], 1u); break; } } } } while (0)
struct XcdBarrier { unsigned* bar; unsigned x; volatile LAS unsigned* st; };
__device__ __forceinline__ XcdBarrier xcd_barrier_post(unsigned* bar, volatile LAS unsigned* st) {
    XcdBarrier b; b.bar = bar; b.x = xb_xcc_id(); b.st = st;
    if (threadIdx.x == 0) (void)xb_add(&bar[XB_XCNT(b.x)], 1u);
    return b;
}
__device__ __forceinline__ void xcd_barrier_complete(unsigned* bar, unsigned x, unsigned& nloc, unsigned& nx) {
    const unsigned G = gridDim.x * gridDim.y * gridDim.z;
    unsigned sum, cnt, mine, sp = 0u;
    for (;;) {
        sum = 0u; cnt = 0u; mine = 0u;
#pragma unroll
        for (unsigned j = 0; j < 16; ++j) { const unsigned c = xb_ld(&bar[XB_XCNT(j)]); sum += c; cnt += (c > 0u) ? 1u : 0u; mine = (j == x) ? c : mine; }
        if (sum == G) break;
        __builtin_amdgcn_s_sleep(1);
        if ((++sp & 255u) == 0u) { if (xb_ld(&bar[XB_TMO])) break; if (sp > XB_SPIN_CAP) { atomicAdd(&bar[XB_TMO], 1u); break; } }
    }
    nloc = mine > 0u ? mine : 1u; nx = cnt > 0u ? cnt : 1u;
}
__device__ __forceinline__ void xcd_barrier(const XcdBarrier& b) {
    asm volatile("s_waitcnt vmcnt(0)" ::: "memory");
    __syncthreads();
    if (threadIdx.x == 0) {
        unsigned* bar = b.bar;
        __builtin_amdgcn_s_waitcnt(0);
        unsigned nloc = b.st[0], nx = b.st[1];
        if (nloc == 0u) { xcd_barrier_complete(bar, b.x, nloc, nx); b.st[0] = nloc; b.st[1] = nx; }
        const unsigned old = xb_add(&bar[XB_XSUB(b.x)], 1u);
        const unsigned gen = old / nloc;
        if (old + 1u == (gen + 1u) * nloc) {
            __builtin_amdgcn_fence(__ATOMIC_RELEASE, "agent");
            asm volatile("s_waitcnt vmcnt(0)" ::: "memory");
            const unsigned og = xb_add(&bar[XB_TOP], 1u);
            const unsigned tg = og / nx;
            if (og + 1u == (tg + 1u) * nx) xb_add(&bar[XB_TOPGEN], 1u);
            else XB_SPIN(xb_ld(&bar[XB_TOPGEN]) == tg, bar);
            __builtin_amdgcn_fence(__ATOMIC_ACQUIRE, "agent");
            xb_add(&bar[XB_XGEN(b.x)], 1u);
            asm volatile("s_waitcnt vmcnt(0)" ::: "memory");
        } else {
            XB_SPIN(xb_ld(&bar[XB_XGEN(b.x)]) == gen, bar);
            __builtin_amdgcn_fence(__ATOMIC_ACQUIRE, "agent");
            asm volatile("s_waitcnt vmcnt(0)" ::: "memory");
        }
    }
    __syncthreads();
}

template <bool GATE>
__device__ __forceinline__ void tr_item(const float* src, int ldsrc, int k0s, int n0s, bf16* dst, int lddst, int k0d, int n0d, LAS float* scr, int lane) {
#pragma unroll 8
    for (int i = 0; i < 32; ++i) { const int kk = 2 * i + (lane >> 5); scr[kk * 33 + (lane & 31)] = src ? src[(size_t)(k0s + kk) * ldsrc + n0s + (lane & 31)] : 0.f; }
    asm volatile("s_waitcnt lgkmcnt(0)" ::: "memory");
    const int c = lane & 7;
#pragma unroll
    for (int j = 0; j < 4; ++j) { const int n = (lane >> 3) + 8 * j; const LAS float* s = scr + (8 * c) * 33 + n;
        u32x4 o; o.x = pk2(s[0 * 33], s[1 * 33]); o.y = pk2(s[2 * 33], s[3 * 33]); o.z = pk2(s[4 * 33], s[5 * 33]); o.w = pk2(s[6 * 33], s[7 * 33]);
        int drow = n0d + n;
        if (GATE) { const int nb = drow >> 10, d = drow & 1023, dl = d & 63; drow = (d >> 6) * 256 + 128 * (nb >> 1) + 32 * (dl >> 4) + 8 * ((dl >> 2) & 3) + 4 * (nb & 1) + (dl & 3); }
        *(u32x4*)(dst + (size_t)drow * lddst + k0d + 8 * c) = o; }
    asm volatile("s_waitcnt lgkmcnt(0)" ::: "memory");
}

__device__ __forceinline__ void phase_prologue(const Params& kp, LAS unsigned char* lds, int gw, int NGW, int wave, int lane) {
    asm volatile("" : "+v"(lane)); asm volatile("" : "+s"(gw));
    asm volatile("" : "+s"(wave));
    unsigned char* const ws_ = PWS();
    LAS float* scr = (LAS float*)(lds + wave * 16384);
    constexpr int I_IN = 16 * 67, I_INZ = 16 * 5, I_G = 16 * 128, I_D = 6 * 32, I_B = 4 * 4 * 32, I_O = 16 * 32, I_1 = 16 * 128, I_2 = 64 * 32;
    constexpr int PER = I_IN + I_INZ + I_G + I_D + I_B + I_O + I_1 + I_2;
    for (int it = gw; it < DEPTH * PER; it += NGW) {
        const int l = it / PER; int r = it % PER;
        unsigned char* wb = ws_ + WS_W + (size_t)l * W_LAYER;
        if (r < I_IN) { const int kb = r / 67, nb = r % 67; tr_item<false>(PIN(2) + (size_t)l * 1024 * INW, INW, kb * 64, nb * 32, (bf16*)(wb + WO_IN), 1024, kb * 64, nb * 32, scr, lane); continue; } r -= I_IN;
        if (r < I_INZ) { const int kb = r / 5, nb = r % 5; tr_item<false>(nullptr, 0, 0, 0, (bf16*)(wb + WO_IN), 1024, kb * 64, INW + nb * 32, scr, lane); continue; } r -= I_INZ;
        if (r < I_G) { const int kb = r / 128, nb = r % 128; tr_item<true>(PIN(3) + (size_t)l * 1024 * 4096, 4096, kb * 64, nb * 32, (bf16*)(wb + WO_G), 1024, kb * 64, nb * 32, scr, lane); continue; } r -= I_G;
        if (r < I_D) { const int kb = r / 32, nb = r % 32; const float* src = nullptr; int ld = 0, k0 = 0, n0 = 0;
            if (nb < 12 && kb < 3) { src = PIN(11) + (size_t)l * 192 * 384; ld = 384; k0 = kb * 64; n0 = nb * 32; }
            else if (nb >= 12 && nb < 28 && (kb == 3 || kb == 4)) { src = PIN(12) + (size_t)l * 128 * 512; ld = 512; k0 = (kb - 3) * 64; n0 = (nb - 12) * 32; }
            tr_item<false>(src, ld, k0, n0, (bf16*)(wb + WO_D), 384, kb * 64, nb * 32, scr, lane); continue; } r -= I_D;
        if (r < I_B) { const int n = r / 128, q = r % 128, kb = q / 32, nb = q % 32;
            tr_item<false>(PIN(13) + ((size_t)l * 4 + n) * 256 * 1024, 1024, kb * 64, nb * 32, (bf16*)(wb + WO_B), 256, kb * 64, n * 1024 + nb * 32, scr, lane); continue; } r -= I_B;
        if (r < I_O) { const int kb = r / 32, nb = r % 32; tr_item<false>(PIN(14) + (size_t)l * 1024 * 1024, 1024, kb * 64, nb * 32, (bf16*)(wb + WO_O), 1024, kb * 64, nb * 32, scr, lane); continue; } r -= I_O;
        if (r < I_1) { const int kb = r / 128, nb = r % 128; tr_item<false>(PIN(16) + (size_t)l * 1024 * 4096, 4096, kb * 64, nb * 32, (bf16*)(wb + WO_1), 1024, kb * 64, nb * 32, scr, lane); continue; } r -= I_1;
        { const int kb = r / 32, nb = r % 32; tr_item<false>(PIN(17) + (size_t)l * 4096 * 1024, 1024, kb * 64, nb * 32, (bf16*)(wb + WO_2), 4096, kb * 64, nb * 32, scr, lane); }
    }
    const float inv[16] = {1.000000000e+00f, 5.623413324e-01f, 3.162277639e-01f, 1.778279394e-01f, 1.000000015e-01f, 5.623413250e-02f, 3.162277490e-02f, 1.778279431e-02f,
                           9.999999776e-03f, 5.623413250e-03f, 3.162277630e-03f, 1.778279431e-03f, 1.000000047e-03f, 5.623413017e-04f, 3.162277571e-04f, 1.778279402e-04f};
    float* cosT = (float*)(ws_ + WS_COS); float* sinT = (float*)(ws_ + WS_SIN);
    for (int idx = gw * 64 + lane; idx < SEQ * 16; idx += NGW * 64) {
        const int pos = idx >> 4, i = idx & 15;
        float iv = inv[0];
#pragma unroll
        for (int q = 1; q < 16; ++q) iv = (i == q) ? inv[q] : iv;
        const float angf = (float)pos * iv;
        const double a = (double)angf;
        const double kq = __builtin_rint(a * 0.15915494309189535);
        double rr = __builtin_fma(-kq, 6.283185307179586, a); rr = __builtin_fma(-kq, 2.4492935982947064e-16, rr);
        const double r2 = rr * rr;
        double sp = -1.0 / 1.0888869450418352e28, cp = 1.0 / 4.0329146112660565e26;
        const double fs[13] = {1.0 / 1.5511210043330986e25, -1.0 / 2.5852016738884978e22, 1.0 / 5.109094217170944e19, -1.0 / 1.21645100408832e17, 1.0 / 3.55687428096e14,
                               -1.0 / 1.307674368e12, 1.0 / 6.2270208e9, -1.0 / 3.99168e7, 1.0 / 3.6288e5, -1.0 / 5.04e3, 1.0 / 1.2e2, -1.0 / 6.0, 1.0};
        const double fc[13] = {-1.0 / 6.204484017332394e23, 1.0 / 1.1240007277776077e21, -1.0 / 2.43290200817664e18, 1.0 / 6.402373705728e15, -1.0 / 2.0922789888e13,
                               1.0 / 8.71782912e10, -1.0 / 4.790016e8, 1.0 / 3.6288e6, -1.0 / 4.032e4, 1.0 / 7.2e2, -1.0 / 2.4e1, 1.0 / 2.0, -1.0};
#pragma unroll
        for (int q = 0; q < 13; ++q) { sp = __builtin_fma(sp, r2, fs[q]); cp = __builtin_fma(cp, r2, fc[q]); }
        cosT[idx] = (float)(-cp); sinT[idx] = (float)(sp * rr);
    }
}

__device__ __forceinline__ void phase_norm(const float* __restrict__ x, const float* __restrict__ g, bf16* __restrict__ out, int gw, int NGW, int lane) {
    asm volatile("" : "+v"(lane)); asm volatile("" : "+s"(gw));
    f32x4 gv[4];
#pragma unroll
    for (int j = 0; j < 4; ++j) gv[j] = ((const f32x4*)g)[lane + 64 * j];
    for (int m = gw; m < T_TOK; m += 2 * NGW) {
        const int m2 = m + NGW;
        const f32x4* xr = (const f32x4*)(x + (size_t)m * DM) + lane;
        const f32x4* xr2 = (const f32x4*)(x + (size_t)(m2 < T_TOK ? m2 : m) * DM) + lane;
        f32x4 v[4], w[4]; float s = 0.f, s2 = 0.f;
#pragma unroll
        for (int j = 0; j < 4; ++j) { v[j] = xr[64 * j]; w[j] = xr2[64 * j]; }
#pragma unroll
        for (int j = 0; j < 4; ++j) { s += (v[j].x * v[j].x + v[j].y * v[j].y) + (v[j].z * v[j].z + v[j].w * v[j].w); s2 += (w[j].x * w[j].x + w[j].y * w[j].y) + (w[j].z * w[j].z + w[j].w * w[j].w); }
        const float rstd = 1.0f / sqrtf(wave_sum(s) * (1.f / DM) + EPS), rstd2 = 1.0f / sqrtf(wave_sum(s2) * (1.f / DM) + EPS);
        u32x2* o8 = (u32x2*)(out + (size_t)m * DM) + lane;
#pragma unroll
        for (int j = 0; j < 4; ++j) { u32x2 q; q.x = pk2(v[j].x * rstd * gv[j].x, v[j].y * rstd * gv[j].y); q.y = pk2(v[j].z * rstd * gv[j].z, v[j].w * rstd * gv[j].w); o8[64 * j] = q; }
        if (m2 < T_TOK) { u32x2* o82 = (u32x2*)(out + (size_t)m2 * DM) + lane;
#pragma unroll
            for (int j = 0; j < 4; ++j) { u32x2 q; q.x = pk2(w[j].x * rstd2 * gv[j].x, w[j].y * rstd2 * gv[j].y); q.y = pk2(w[j].z * rstd2 * gv[j].z, w[j].w * rstd2 * gv[j].w); o82[64 * j] = q; } }
    }
}
__device__ __forceinline__ void phase_norm_bf(const bf16* __restrict__ x, const float* __restrict__ g, bf16* __restrict__ out, int gw, int NGW, int lane) {
    asm volatile("" : "+v"(lane)); asm volatile("" : "+s"(gw));
    f32x4 gv[2][2];
#pragma unroll
    for (int j = 0; j < 2; ++j) { gv[j][0] = *(const f32x4*)(g + 8 * lane + 512 * j); gv[j][1] = *(const f32x4*)(g + 8 * lane + 512 * j + 4); }
    for (int m = gw; m < T_TOK; m += 2 * NGW) {
        const int m2 = (m + NGW) < T_TOK ? (m + NGW) : m;
        u32x4 a[2], b[2];
#pragma unroll
        for (int j = 0; j < 2; ++j) { a[j] = *(const u32x4*)(x + (size_t)m * DM + 8 * lane + 512 * j); b[j] = *(const u32x4*)(x + (size_t)m2 * DM + 8 * lane + 512 * j); }
        float s1 = 0.f, s2 = 0.f;
#pragma unroll
        for (int j = 0; j < 2; ++j)
#pragma unroll
            for (int e = 0; e < 4; ++e) { const float p = bflo(a[j][e]), q = bfhi(a[j][e]), r = bflo(b[j][e]), t = bfhi(b[j][e]); s1 += p * p + q * q; s2 += r * r + t * t; }
        const float rs1 = 1.0f / sqrtf(wave_sum(s1) * (1.f / DM) + EPS), rs2 = 1.0f / sqrtf(wave_sum(s2) * (1.f / DM) + EPS);
#pragma unroll
        for (int j = 0; j < 2; ++j) { u32x4 w1, w2;
#pragma unroll
            for (int e = 0; e < 4; ++e) { const float g0 = gv[j][e >> 1][(e & 1) * 2], g1 = gv[j][e >> 1][(e & 1) * 2 + 1];
                w1[e] = pk2(bflo(a[j][e]) * rs1 * g0, bfhi(a[j][e]) * rs1 * g1); w2[e] = pk2(bflo(b[j][e]) * rs2 * g0, bfhi(b[j][e]) * rs2 * g1); }
            *(u32x4*)(out + (size_t)m * DM + 8 * lane + 512 * j) = w1;
            if (m2 != m) *(u32x4*)(out + (size_t)m2 * DM + 8 * lane + 512 * j) = w2; }
    }
}
__device__ __forceinline__ void phase_final_norm(const bf16* __restrict__ x, const float* __restrict__ g, float* __restrict__ out, int gw, int NGW, int lane) {
    asm volatile("" : "+v"(lane)); asm volatile("" : "+s"(gw));
    f32x4 gv[2][2];
#pragma unroll
    for (int j = 0; j < 2; ++j) { gv[j][0] = *(const f32x4*)(g + 8 * lane + 512 * j); gv[j][1] = *(const f32x4*)(g + 8 * lane + 512 * j + 4); }
    for (int m = gw; m < T_TOK; m += 2 * NGW) {
        const int m2 = (m + NGW) < T_TOK ? (m + NGW) : m;
        u32x4 a[2], b[2];
#pragma unroll
        for (int j = 0; j < 2; ++j) { a[j] = *(const u32x4*)(x + (size_t)m * DM + 8 * lane + 512 * j); b[j] = *(const u32x4*)(x + (size_t)m2 * DM + 8 * lane + 512 * j); }
        float s1 = 0.f, s2 = 0.f;
#pragma unroll
        for (int j = 0; j < 2; ++j)
#pragma unroll
            for (int e = 0; e < 4; ++e) { const float p = bflo(a[j][e]), q = bfhi(a[j][e]), r = bflo(b[j][e]), t = bfhi(b[j][e]); s1 += p * p + q * q; s2 += r * r + t * t; }
        const float rs1 = 1.0f / sqrtf(wave_sum(s1) * (1.f / DM) + EPS), rs2 = 1.0f / sqrtf(wave_sum(s2) * (1.f / DM) + EPS);
#pragma unroll
        for (int j = 0; j < 2; ++j) {
            float* o1 = out + (size_t)m * DM + 8 * lane + 512 * j; float* o2 = out + (size_t)m2 * DM + 8 * lane + 512 * j;
            const f32x4 x0 = (f32x4){bflo(a[j][0]), bfhi(a[j][0]), bflo(a[j][1]), bfhi(a[j][1])}, x1 = (f32x4){bflo(a[j][2]), bfhi(a[j][2]), bflo(a[j][3]), bfhi(a[j][3])};
            const f32x4 y0 = (f32x4){bflo(b[j][0]), bfhi(b[j][0]), bflo(b[j][1]), bfhi(b[j][1])}, y1 = (f32x4){bflo(b[j][2]), bfhi(b[j][2]), bflo(b[j][3]), bfhi(b[j][3])};
            *(f32x4*)o1 = x0 * rs1 * gv[j][0]; *(f32x4*)(o1 + 4) = x1 * rs1 * gv[j][1];
            if (m2 != m) { *(f32x4*)o2 = y0 * rs2 * gv[j][0]; *(f32x4*)(o2 + 4) = y1 * rs2 * gv[j][1]; } }
    }
}

__device__ __forceinline__ void phase_prep(const Params& kp, LAS unsigned char* lds, int l, int gw, int NGW, int lane) {
    asm volatile("" : "+v"(lane)); asm volatile("" : "+s"(gw));
    unsigned char* const ws_ = PWS();
    bf16* QKV = (bf16*)(ws_ + WS_BIG + BIG_QKV); bf16* DA = (bf16*)(ws_ + WS_BIG + BIG_DA); bf16* KR = (bf16*)(ws_ + WS_BIG + BIG_KR);
    const float* cosT = (const float*)(ws_ + WS_COS); const float* sinT = (const float*)(ws_ + WS_SIN);
    const float* gq = PIN(5) + l * 64; const float* gk = PIN(6) + l * 64; const float* gdq = PIN(9) + l * 192; const float* gdkv = PIN(10) + l * 128;
    const int m16 = lane & 15;
    const f32x4 gq4 = *(const f32x4*)(gq + m16 * 4), gk4 = *(const f32x4*)(gk + m16 * 4);
    const f32x4 gdq4 = lane < 48 ? *(const f32x4*)(gdq + lane * 4) : (f32x4){0.f, 0.f, 0.f, 0.f};
    const f32x4 gdkv4 = lane < 32 ? *(const f32x4*)(gdkv + lane * 4) : (f32x4){0.f, 0.f, 0.f, 0.f};
    const float CA = 0.125f * 1.4426950408889634f;
    for (int t = gw; t < T_TOK; t += NGW) {
        bf16* row = QKV + (size_t)t * INWP;
        const int tin = t & (SEQ - 1), prow = tin >> 6, pcol = tin & 63;
        const int blk = m16 >> 3, i0 = (m16 & 7) * 4, ti = i0 & 15; const bool isx2 = i0 >= 16;
        const int posA = blk ? pcol : prow;
        const u32x2 wq = *(const u32x2*)(row + 4 * lane);
        const u32x2 wk = lane < 32 ? *(const u32x2*)(row + 256 + 4 * lane) : (u32x2){0u, 0u};
        const u32x2 wcq = lane < 48 ? *(const u32x2*)(row + 1792 + 4 * lane) : (u32x2){0u, 0u};
        const u32x2 wckv = lane < 32 ? *(const u32x2*)(row + 1984 + 4 * lane) : (u32x2){0u, 0u};
        const u32x2 wkr = lane < 8 ? *(const u32x2*)(row + 2112 + 4 * lane) : (u32x2){0u, 0u};
        const f32x4 cA = *(const f32x4*)(cosT + posA * 16 + ti), sA = *(const f32x4*)(sinT + posA * 16 + ti);
        const f32x4 cD = *(const f32x4*)(cosT + tin * 16 + ti), sD = *(const f32x4*)(sinT + tin * 16 + ti);
#pragma unroll
        for (int pass = 0; pass < 2; ++pass) {
            const bool act = (pass == 0) || (lane < 32);
            bf16* ptr = row + pass * 256 + 4 * lane;
            const u32x2 w = pass == 0 ? wq : wk;
            float x[4] = {bflo(w.x), bfhi(w.x), bflo(w.y), bfhi(w.y)};
            float ss = (x[0] * x[0] + x[1] * x[1]) + (x[2] * x[2] + x[3] * x[3]);
            ss += __shfl_xor(ss, 1); ss += __shfl_xor(ss, 2); ss += __shfl_xor(ss, 4); ss += __shfl_xor(ss, 8);
            const float rstd = 1.0f / sqrtf(ss * (1.f / 64.f) + EPS);
            const f32x4 g4 = pass == 0 ? gq4 : gk4;
            float y[4], o[4];
#pragma unroll
            for (int e = 0; e < 4; ++e) y[e] = x[e] * rstd * g4[e];
#pragma unroll
            for (int e = 0; e < 4; ++e) { const float pr = __shfl_xor(y[e], 4); o[e] = isx2 ? (y[e] * cA[e] + pr * sA[e]) : (y[e] * cA[e] - pr * sA[e]); if (pass == 0) o[e] *= CA; }
            if (act) { u32x2 ow; ow.x = pk2(o[0], o[1]); ow.y = pk2(o[2], o[3]); *(u32x2*)ptr = ow; }
        }
        {
            float x[4] = {bflo(wcq.x), bfhi(wcq.x), bflo(wcq.y), bfhi(wcq.y)};
            const float ss = wave_sum((x[0] * x[0] + x[1] * x[1]) + (x[2] * x[2] + x[3] * x[3]));
            const float rstd = 1.0f / sqrtf(ss * (1.f / 192.f) + EPS);
            if (lane < 48) { u32x2 ow; ow.x = pk2(x[0] * rstd * gdq4[0], x[1] * rstd * gdq4[1]); ow.y = pk2(x[2] * rstd * gdq4[2], x[3] * rstd * gdq4[3]); *(u32x2*)(DA + (size_t)t * 384 + 4 * lane) = ow; }
        }
        {
            float x[4] = {bflo(wckv.x), bfhi(wckv.x), bflo(wckv.y), bfhi(wckv.y)};
            const float ss = wave_sum((x[0] * x[0] + x[1] * x[1]) + (x[2] * x[2] + x[3] * x[3]));
            const float rstd = 1.0f / sqrtf(ss * (1.f / 128.f) + EPS);
            u32x2 ow; ow.x = pk2(x[0] * rstd * gdkv4[0], x[1] * rstd * gdkv4[1]); ow.y = pk2(x[2] * rstd * gdkv4[2], x[3] * rstd * gdkv4[3]);
            if (lane >= 32) { ow.x = 0u; ow.y = 0u; }
            if (lane < 48) *(u32x2*)(DA + (size_t)t * 384 + 192 + 4 * lane) = ow;
        }
        {
            float x[4] = {bflo(wkr.x), bfhi(wkr.x), bflo(wkr.y), bfhi(wkr.y)};
            float o[4];
#pragma unroll
            for (int e = 0; e < 4; ++e) { const float pr = __shfl_xor(x[e], 4); o[e] = isx2 ? (x[e] * cD[e] + pr * sD[e]) : (x[e] * cD[e] - pr * sD[e]); }
            if (lane < 8) { u32x2 ow; ow.x = pk2(o[0], o[1]); ow.y = pk2(o[2], o[3]); *(u32x2*)(KR + (size_t)t * 32 + 4 * lane) = ow; }
        }
    }
}

__device__ __forceinline__ void phase_attention(const Params& kp, LAS unsigned char* lds, int l, char* ldsg, int vcu, int G) {
    asm volatile("" : "+s"(vcu));
    unsigned char* const ws_ = PWS();
    const bf16* QKV = (const bf16*)(ws_ + WS_BIG + BIG_QKV); const bf16* DX = (const bf16*)(ws_ + WS_BIG + BIG_DX); const bf16* KR = (const bf16*)(ws_ + WS_BIG + BIG_KR);
    bf16* BR = (bf16*)(ws_ + WS_BR);
    const int upc = (512 + G - 1) / G, u0 = vcu * upc, u1 = (u0 + upc) < 512 ? (u0 + upc) : 512;
    const float L2E = 1.4426950408889634f;
    att::UnitP P;
    P.cosT = (const float*)(ws_ + WS_COS); P.sinT = (const float*)(ws_ + WS_SIN); P.slope2 = 0.f; P.sink2 = 0.f; P.cscale = 1.f; P.K2 = nullptr;
    bool nomaxA;
    { const int ln = threadIdx.x & 63; float gq = fabsf(PIN(5)[l * 64 + ln]), gk = fabsf(PIN(6)[l * 64 + ln]);
#pragma unroll
      for (int o_ = 1; o_ < 64; o_ <<= 1) { gq = fmaxf(gq, __shfl_xor(gq, o_)); gk = fmaxf(gk, __shfl_xor(gk, o_)); }
      const float bound2 = 8.f * gq * gk * L2E * 1.02f;
      nomaxA = __builtin_amdgcn_readfirstlane(bound2 <= 40.f ? 1 : 0) != 0; }
    if (AEN(0)) for (int u = u0; u < u1; ++u) { const int bh = u >> 6, qb = u & 63, b = bh >> 2, h = bh & 3; const size_t r0 = (size_t)b * SEQ;
        P.Q = QKV + (r0 + qb * 256) * INWP + h * 64; P.K = QKV + r0 * INWP + 256 + (h >> 1) * 64; P.V = QKV + r0 * INWP + 384 + (h >> 1) * 64; P.O = BR + (r0 + qb * 256) * 1024 + h * 64;
        P.ldq = INWP; P.ldk = INWP; P.ldv = INWP; P.ldo = 1024; P.t_lo = 0; P.nt = 256; P.q0 = qb * 256;
        if (nomaxA) att::attn_unit<0, true>(P, ldsg); else att::attn_unit<0, false>(P, ldsg); }
    if (AEN(1)) for (int u = u0; u < u1; ++u) { const int bh = u >> 6, qb = u & 63, b = bh >> 2, h = bh & 3; const size_t r0 = (size_t)b * SEQ;
        P.Q = DX + (r0 + qb * 256) * 1024 + h * 96; P.K = DX + r0 * 1024 + 384 + h * 128; P.V = DX + r0 * 1024 + 384 + h * 128 + 64; P.K2 = KR + r0 * 32; P.O = BR + (r0 + qb * 256) * 1024 + 768 + h * 64;
        P.ldq = 1024; P.ldk = 1024; P.ldv = 1024; P.ldo = 1024; P.t_lo = 0; P.nt = 256; P.q0 = qb * 256; P.cscale = 0.10206207261596575f * L2E;
        att::attn_unit<1>(P, ldsg); }
    if (AEN(3)) for (int u = u0; u < u1; ++u) { const int bh = u >> 6, qb = u & 63, b = bh >> 2, h = bh & 3; const size_t r0 = (size_t)b * SEQ;
        P.Q = QKV + (r0 + qb * 256) * INWP + 1280 + h * 64; P.K = QKV + r0 * INWP + 1536 + (h >> 1) * 64; P.V = QKV + r0 * INWP + 1664 + (h >> 1) * 64; P.O = BR + (r0 + qb * 256) * 1024 + 512 + h * 64;
        P.ldq = INWP; P.ldk = INWP; P.ldv = INWP; P.ldo = 1024; P.q0 = qb * 256;
        int lo = qb * 4 - 2, hi = qb * 4 + 6; lo = lo < 0 ? 0 : lo; hi = hi > 256 ? 256 : hi; P.t_lo = lo; P.nt = hi - lo;
        P.cscale = 0.125f * L2E; P.slope2 = __builtin_amdgcn_exp2f(-2.f * (float)(h + 1)) * L2E; P.sink2 = PIN(8)[l * 4 + h] * L2E;
        att::attn_unit<3>(P, ldsg); }
    if (AEN(2)) for (int u = u0; u < u1; ++u) { const int bh = u >> 6, qb = u & 63, b = bh >> 2, h = bh & 3; const size_t r0 = (size_t)b * SEQ;
        { float* tab = (float*)(ldsg + att::OFF_TAB); const float* src = PIN(7) + ((size_t)l * 4 + h) * 465;
          for (int i = threadIdx.x; i < 466; i += 512) tab[i] = i < 465 ? src[i] * L2E : -INFINITY;
          __syncthreads(); }
        P.Q = QKV + (r0 + qb * 256) * INWP + 512 + h * 64; P.K = QKV + r0 * INWP + 768 + h * 64; P.V = QKV + r0 * INWP + 1024 + h * 64; P.O = BR + (r0 + qb * 256) * 1024 + 256 + h * 64;
        P.ldq = INWP; P.ldk = INWP; P.ldv = INWP; P.ldo = 1024; P.q0 = qb * 256;
        const int ra = qb * 4, rb = qb * 4 + 3;
        int lo = ra - 4; lo = lo < 0 ? 0 : (lo > 248 ? 248 : lo);
        int hi = rb - 4; hi = hi < 0 ? 0 : (hi > 248 ? 248 : hi); hi += 8;
        if ((hi - lo) & 1) { if (hi < 256) ++hi; else --lo; }
        P.t_lo = lo; P.nt = hi - lo; P.cscale = 0.125f * L2E;
        att::attn_unit<2>(P, ldsg); }
}

template <int S_>
__device__ __forceinline__ void run_sub(const Params& kp, int l, LAS unsigned char* lds, unsigned char* lds_raw, int gw, int NGW, int lane, int vcu, int G, int bx) {
    constexpr int s = S_;
    unsigned char* ws = PWS();
    bf16* H = (bf16*)POUT();
    bf16* XR = (bf16*)(ws + WS_H);
    bf16* BR = (bf16*)(ws + WS_BR); bf16* BIG = (bf16*)(ws + WS_BIG);
    unsigned char* wb = ws + WS_W + (size_t)l * W_LAYER;
    pg8::StaticOrder S;
    if constexpr (s == 0) { if (EN(1)) { if (l == 0) phase_norm(PIN(0), PIN(1), H, gw, NGW, lane); else phase_norm_bf(XR, PIN(1) + l * DM, H, gw, NGW, lane); } }
    else if constexpr (s == 2) { if (EN(3)) phase_prep(kp, lds, l, gw, NGW, lane); }
    else if constexpr (s == 4) { if (EN(5)) { phase_attention(kp, lds, l, (char*)lds_raw, vcu, G); if (PROBE_DUP == 1 && l == 0) { __syncthreads(); phase_attention(kp, lds, l, (char*)lds_raw, vcu, G); } } }
    else if constexpr (s == 8) { if (EN(9)) phase_norm_bf(XR, PIN(15) + l * DM, H, gw, NGW, lane); }
    else if constexpr (s == 1 || s == 3 || s == 5) {
        if (EN(2)) {
        pg8::Gemm g; pg8::EpiBf16<0> E;
        if (s == 1) { g = pg8::Gemm{H, (const bf16*)(wb + WO_IN), T_TOK, INWP, DM, DM, DM, 30, 0}; E = pg8::EpiBf16<0>{BIG + BIG_QKV / 2, INWP}; }
        else if (s == 3) { g = pg8::Gemm{BIG + BIG_DA / 2, (const bf16*)(wb + WO_D), T_TOK, 1024, 384, 384, 384, 30, 0}; E = pg8::EpiBf16<0>{BIG + BIG_DX / 2, 1024}; }
        else { g = pg8::Gemm{BR, (const bf16*)(wb + WO_B), T_TOK, 4096, 256, 1024, 256, 2, 256}; E = pg8::EpiBf16<0>{BIG, 4096}; }
        S.init(T_TOK, g.N, G, bx);
        pg8::gemm_phase<pg8::EpiBf16<0>, true>(lds, g, S, E); } }
    else if constexpr (s == 6) {
        if (EN(7)) {
        pg8::Gemm g{H, (const bf16*)(wb + WO_G), T_TOK, 4096, DM, DM, DM, 30, 0}; S.init(T_TOK, 4096, G, bx);
        pg8::EpiMerge E{BIG, PIN(4) + (size_t)l * 4096, BR};
        pg8::gemm_phase<pg8::EpiMerge, true>(lds, g, S, E); } }
    else if constexpr (s == 9) {
        if (EN(10)) {
        pg8::Gemm g{H, (const bf16*)(wb + WO_1), T_TOK, FF, DM, DM, DM, 30, 0}; S.init(T_TOK, FF, G, bx);
        pg8::EpiBf16<1> E{BIG, FF};
        pg8::gemm_phase<pg8::EpiBf16<1>, true>(lds, g, S, E);
        if (PROBE_DUP == 2 && l == 0) pg8::gemm_phase<pg8::EpiBf16<1>, true>(lds, g, S, E); } }
    else {
        if (EN(8)) {
        pg8::Gemm g;
        if (s == 7) g = pg8::Gemm{BR, (const bf16*)(wb + WO_O), T_TOK, DM, DM, DM, DM, 30, 0};
        else g = pg8::Gemm{BIG, (const bf16*)(wb + WO_2), T_TOK, DM, FF, FF, FF, 30, 0};
        S.init(T_TOK, DM, G, bx);
        if (s == 7 && l == 0) { pg8::EpiRes<false> E{PIN(0), XR, DM}; pg8::gemm_phase<pg8::EpiRes<false>, true>(lds, g, S, E); }
        else { pg8::EpiRes<true> E{XR, XR, DM}; pg8::gemm_phase<pg8::EpiRes<true>, true>(lds, g, S, E); } } }
}

__global__ void __launch_bounds__(512, 2) fwd_megakernel(Params p) {
    extern __shared__ __attribute__((aligned(16))) unsigned char lds_raw[];
    cg::grid_group grid = cg::this_grid();
    LAS unsigned char* lds = (LAS unsigned char*)lds_raw;
    const int tid = threadIdx.x, lane = tid & 63, wave = __builtin_amdgcn_readfirstlane(tid >> 6);
    const int G = gridDim.x, bx = blockIdx.x;
    const int vcu = (G % 8 == 0) ? (bx % 8) * (G / 8) + bx / 8 : bx;
    const int gw = vcu * 8 + wave, NGW = G * 8;
    const int ph_lo = p.ph_lo, ph_hi = p.ph_hi;
    volatile LAS unsigned* MISC = (volatile LAS unsigned*)(lds + PAR_OFF);
    if (tid < 2) MISC[tid] = 0u;
    __syncthreads();
    const XcdBarrier xbar = xcd_barrier_post((unsigned*)p.ws, MISC);
#define RUN_PH(ph, ...) do { if (ph_lo <= (ph) && (ph) < ph_hi) { __VA_ARGS__; if ((ph) + 1 < ph_hi) { if ((ph) == 0) grid.sync(); else xcd_barrier(xbar); } } } while (0)
#define RUN_SUB(L, S_) RUN_PH(1 + (L) * 11 + (S_), run_sub<S_>(p, (L), lds, lds_raw, gw, NGW, lane, vcu, G, bx))
#define RUN_LAYER(L) do { RUN_SUB(L, 0); RUN_SUB(L, 1); RUN_SUB(L, 2); RUN_SUB(L, 3); RUN_SUB(L, 4); RUN_SUB(L, 5); RUN_SUB(L, 6); RUN_SUB(L, 7); RUN_SUB(L, 8); RUN_SUB(L, 9); RUN_SUB(L, 10); } while (0)
    RUN_PH(0, if (EN(0)) phase_prologue(p, lds, gw, NGW, wave, lane));
    RUN_LAYER(0);
    RUN_LAYER(1);
    RUN_PH(23, if (EN(12)) phase_final_norm((const bf16*)(p.ws + WS_H), p.in[18], p.out, gw, NGW, lane));
}

extern "C" void kernel_launch(void* const* d_in, const int* in_sizes, int n_in, void* d_out, int out_size, void* d_ws, size_t ws_size, hipStream_t stream) {
    static int grid = 0;
    if (grid == 0) {
        if (n_in != 19 || in_sizes[0] != T_TOK * DM || out_size != T_TOK * DM || ws_size < WS_END) {
            fprintf(stderr, "kernel_launch: unexpected shapes (n_in %d, in0 %d, out %d, ws %zu); nothing launched\n", n_in, n_in > 0 ? in_sizes[0] : -1, out_size, ws_size); grid = -1; return; }
        int dev = 0, cus = 0, per_cu = 0;
        if (hipGetDevice(&dev) != hipSuccess || hipDeviceGetAttribute(&cus, hipDeviceAttributeMultiprocessorCount, dev) != hipSuccess) { grid = -1; return; }
        if (hipFuncSetAttribute((const void*)fwd_megakernel, hipFuncAttributeMaxDynamicSharedMemorySize, LDS_TOTAL) != hipSuccess) { fprintf(stderr, "kernel_launch: hipFuncSetAttribute failed\n"); grid = -1; return; }
        if (hipOccupancyMaxActiveBlocksPerMultiprocessor(&per_cu, (const void*)fwd_megakernel, 512, LDS_TOTAL) != hipSuccess || per_cu < 1) { fprintf(stderr, "kernel_launch: occupancy query failed (%d)\n", per_cu); per_cu = 1; }
        (void)hipGetLastError();
        grid = cus * per_cu;
    }
    if (grid < 0) return;
    if (hipMemsetAsync(d_ws, 0, 16384, stream) != hipSuccess) { fprintf(stderr, "kernel_launch: memset of the barrier words failed\n"); return; }
    Params prm{};
    for (int i = 0; i < 19; ++i) prm.in[i] = (const float*)d_in[i];
    prm.out = (float*)d_out; prm.ws = (unsigned char*)d_ws;
#if MK_PER_PHASE
    for (int ph = 0; ph < 24; ++ph) { prm.ph_lo = ph; prm.ph_hi = ph + 1; void* args[] = {&prm};
        hipError_t e = hipLaunchCooperativeKernel((const void*)fwd_megakernel, dim3(grid), dim3(512), args, LDS_TOTAL, stream);
        if (e != hipSuccess) { fprintf(stderr, "cooperative launch failed: %s (grid %d)\n", hipGetErrorString(e), grid); break; } }
#else
    prm.ph_lo = 0; prm.ph_hi = 24; void* args[] = {&prm};
    hipError_t e = hipLaunchCooperativeKernel((const void*)fwd_megakernel, dim3(grid), dim3(512), args, LDS_TOTAL, stream);
    if (e != hipSuccess) fprintf(stderr, "cooperative launch failed: %s (grid %d)\n", hipGetErrorString(e), grid);
#endif
}
```

```cpp
#include <hip/hip_runtime.h>
#include <hip/hip_cooperative_groups.h>
#include <cstdio>
#include <cstdint>
namespace cg = cooperative_groups;

#ifndef PROBE_DUP
#define PROBE_DUP 0
#endif
#ifndef MK_PER_PHASE
#define MK_PER_PHASE 0
#endif

namespace pg8 {
#define PG8_LAS __attribute__((address_space(3)))
typedef unsigned short bf16_t;
typedef short bf16x8 __attribute__((ext_vector_type(8)));
typedef float f32x4 __attribute__((ext_vector_type(4)));
typedef float f32x2 __attribute__((ext_vector_type(2)));
typedef unsigned u32x4 __attribute__((ext_vector_type(4)));
typedef unsigned u32x2 __attribute__((ext_vector_type(2)));
constexpr int BM = 256, BK = 64, HALF = 128, HTB = HALF * BK * 2, STAGE_BYTES = 8 * HTB, NXCD = 8, WGM = 8;

__host__ __device__ __forceinline__ int lds_byte(int r, int c) { const int st = (r >> 4) * 2 + (c >> 5), rr = r & 15, cc = c & 31, ob = rr * 64 + cc * 2; return st * 1024 + (ob ^ (((ob >> 9) & 1) << 5)); }
__host__ __device__ __forceinline__ void stage_rc(int b, int& R, int& C) { const int st = b / 1024, sb = b % 1024, swz = sb ^ (((sb >> 9) & 1) << 5); R = (st >> 1) * 16 + swz / 64; C = (st & 1) * 32 + (swz % 64) / 2; }
__host__ __device__ __forceinline__ int perm32(int rho) { const int n = rho >> 4, i = rho & 15; return 8 * (i >> 2) + 4 * n + (i & 3); }

struct Unit { int pm, pn; };
struct Gemm { const bf16_t* A; const bf16_t* Bt; int M, N, K, lda, ldb, a_shift, a_zoff; };

struct StaticOrder {
    int nM, nN, nwg, G, c;
    __device__ void init(int M, int N, int G_, int c_) { nM = M / BM; nN = N / BM; nwg = nM * nN; G = G_; c = c_; }
    __device__ bool next(int i, Unit& u) const {
        const long L = (long)i * G + c; if (L >= nwg) return false;
        int wgid = (int)L; { const int q = nwg / NXCD, r = nwg % NXCD, xcd = wgid % NXCD, off = wgid / NXCD; wgid = (xcd < r ? xcd * (q + 1) : r * (q + 1) + (xcd - r) * q) + off; }
        const int nig = WGM * nN, gid = wgid / nig, fm = gid * WGM, gsz = (nM - fm) < WGM ? (nM - fm) : WGM;
        u.pm = fm + ((wgid % nig) % gsz); u.pn = (wgid % nig) / gsz; return true;
    }
};

__device__ __forceinline__ unsigned cvt_pk_bf16(float lo, float hi) { unsigned r; asm volatile("v_cvt_pk_bf16_f32 %0, %1, %2" : "=v"(r) : "v"(lo), "v"(hi)); return r; }
__device__ __forceinline__ float bf_lo(unsigned w) { return __uint_as_float(w << 16); }
__device__ __forceinline__ float bf_hi(unsigned w) { return __uint_as_float(w & 0xffff0000u); }

template <int ACT  > struct EpiBf16 {
    static constexpr bool PERM = true;
    bf16_t* O; int ldc;
    __device__ __forceinline__ void operator()(const f32x4 (&acc)[2][2][4][2], const Unit& u, int wr, int wc, int fr, int fq) const {
        const int row0 = u.pm * BM + wr * 64 + fr, col0 = u.pn * BM + wc * 32 + 8 * fq;
#pragma unroll
        for (int ai = 0; ai < 2; ++ai)
#pragma unroll
            for (int m = 0; m < 4; ++m) { bf16_t* rowp = O + (size_t)(row0 + ai * HALF + m * 16) * ldc + col0;
#pragma unroll
                for (int bj = 0; bj < 2; ++bj) { f32x4 v0 = acc[ai][bj][m][0], v1 = acc[ai][bj][m][1];
                    if (ACT == 1) {
#pragma unroll
                        for (int e = 0; e < 4; ++e) { float a = fmaxf(v0[e], 0.f), b = fmaxf(v1[e], 0.f); v0[e] = a * a; v1[e] = b * b; } }
                    u32x4 w; w.x = cvt_pk_bf16(v0[0], v0[1]); w.y = cvt_pk_bf16(v0[2], v0[3]); w.z = cvt_pk_bf16(v1[0], v1[1]); w.w = cvt_pk_bf16(v1[2], v1[3]);
                    *(u32x4*)(rowp + bj * HALF) = w; } }
    }
};
struct EpiMerge {
    static constexpr bool PERM = true;
    const bf16_t* Y; const float* bg; bf16_t* Z;
    __device__ __forceinline__ void operator()(const f32x4 (&acc)[2][2][4][2], const Unit& u, int wr, int wc, int fr, int fq) const {
        const int row0 = u.pm * BM + wr * 64 + fr, dcol = u.pn * 64 + 16 * wc + 4 * fq;
        f32x4 bv[2][2];
#pragma unroll
        for (int bj = 0; bj < 2; ++bj)
#pragma unroll
            for (int n = 0; n < 2; ++n) bv[bj][n] = *(const f32x4*)(bg + (2 * bj + n) * 1024 + dcol);
#pragma unroll
        for (int ai = 0; ai < 2; ++ai)
#pragma unroll
            for (int m = 0; m < 4; ++m) { const size_t r = (size_t)(row0 + ai * HALF + m * 16);
                const bf16_t* yp = Y + r * 4096 + dcol;
                f32x4 z = (f32x4){0.f, 0.f, 0.f, 0.f};
#pragma unroll
                for (int bj = 0; bj < 2; ++bj)
#pragma unroll
                    for (int n = 0; n < 2; ++n) { const u32x2 yw = *(const u32x2*)(yp + (2 * bj + n) * 1024);
                        const f32x4 y = (f32x4){bf_lo(yw.x), bf_hi(yw.x), bf_lo(yw.y), bf_hi(yw.y)};
                        const f32x4 a = acc[ai][bj][m][n] + bv[bj][n];
#pragma unroll
                        for (int e = 0; e < 4; ++e) z[e] += __builtin_amdgcn_rcpf(1.f + __builtin_amdgcn_exp2f(a[e] * -1.4426950408889634f)) * y[e]; }
                u32x2 w; w.x = cvt_pk_bf16(z[0], z[1]); w.y = cvt_pk_bf16(z[2], z[3]);
                *(u32x2*)(Z + r * 1024 + dcol) = w; }
    }
};
template <bool BBF> struct EpiRes {
    static constexpr bool PERM = true;
    const void* base; bf16_t* out; int ldc;
    __device__ __forceinline__ void operator()(const f32x4 (&acc)[2][2][4][2], const Unit& u, int wr, int wc, int fr, int fq) const {
        const int row0 = u.pm * BM + wr * 64 + fr, col0 = u.pn * BM + wc * 32 + 8 * fq;
#pragma unroll
        for (int ai = 0; ai < 2; ++ai)
#pragma unroll
            for (int m = 0; m < 4; ++m) { const size_t off = (size_t)(row0 + ai * HALF + m * 16) * ldc + col0;
#pragma unroll
                for (int bj = 0; bj < 2; ++bj) { f32x4 b0, b1;
                    if (BBF) { const u32x4 w = *(const u32x4*)((const bf16_t*)base + off + bj * HALF);
                        b0 = (f32x4){bf_lo(w.x), bf_hi(w.x), bf_lo(w.y), bf_hi(w.y)}; b1 = (f32x4){bf_lo(w.z), bf_hi(w.z), bf_lo(w.w), bf_hi(w.w)}; }
                    else { const float* bp = (const float*)base + off + bj * HALF; b0 = *(const f32x4*)bp; b1 = *(const f32x4*)(bp + 4); }
                    const f32x4 v0 = b0 + acc[ai][bj][m][0], v1 = b1 + acc[ai][bj][m][1];
                    u32x4 w; w.x = cvt_pk_bf16(v0[0], v0[1]); w.y = cvt_pk_bf16(v0[2], v0[3]); w.z = cvt_pk_bf16(v1[0], v1[1]); w.w = cvt_pk_bf16(v1[2], v1[3]);
                    *(u32x4*)(out + off + bj * HALF) = w; } }
    }
};

template <class Epi, bool ALIGN_EPI>
__device__ __forceinline__ void gemm_phase(PG8_LAS unsigned char* lds, const Gemm g, const StaticOrder& S, const Epi& E) {
    int tid = threadIdx.x; asm volatile("" : "+v"(tid));
    const int wid = __builtin_amdgcn_readfirstlane(tid >> 6), lane = tid & 63, wr = wid >> 2, wc = wid & 3, fr = lane & 15, fq = lane >> 4;
    const int K = g.K, nt = K / BK;
    unsigned voffA[2], voffB[2];
#pragma unroll
    for (int i = 0; i < 2; ++i) { int R, C; stage_rc(tid * 16 + i * 8192, R, C); const int Rb = Epi::PERM ? ((R & ~31) + perm32(R & 31)) : R;
        voffA[i] = (unsigned)(R * g.lda + C) * 2u; voffB[i] = (unsigned)(Rb * g.ldb + C) * 2u; }
    const size_t kstep = (size_t)(BK * 2);
    const size_t hstepA = (size_t)HALF * g.lda * 2, hstepB = (size_t)HALF * g.ldb * 2;
    const size_t tstepA = 2 * hstepA, tstepB = 2 * hstepB;
    const unsigned ldsw = (unsigned)wid * 1024u;
    const int aoff = lds_byte(wr * 64 + fr, fq * 8), boff = lds_byte(wc * 32 + fr, fq * 8);
#define PG8_SA(b, h) (((b) * 2 + (h)) * HTB)
#define PG8_SB(b, h) ((4 + (b) * 2 + (h)) * HTB)
#define PG8_STAGE(bufoff, gbase, voff) do { _Pragma("unroll") for (int _i = 0; _i < 2; ++_i) \
        __builtin_amdgcn_global_load_lds((const unsigned*)((const char*)(gbase) + (voff)[_i]), (PG8_LAS unsigned*)(lds + (bufoff) + ldsw + _i * 8192), 16, 0, 0); } while (0)
#define PG8_LDA(dst, b, h) do { _Pragma("unroll") for (int m = 0; m < 4; ++m) _Pragma("unroll") for (int k = 0; k < 2; ++k) dst[m][k] = *(const PG8_LAS bf16x8*)(lds + PG8_SA(b, h) + aoff + m * 2048 + k * 1024); } while (0)
#define PG8_LDB(dst, b, h) do { _Pragma("unroll") for (int n = 0; n < 2; ++n) _Pragma("unroll") for (int k = 0; k < 2; ++k) dst[n][k] = *(const PG8_LAS bf16x8*)(lds + PG8_SB(b, h) + boff + n * 2048 + k * 1024); } while (0)
#define PG8_MMA(ai, bj, At, Bt) do { __builtin_amdgcn_s_setprio(1); _Pragma("unroll") for (int m = 0; m < 4; ++m) _Pragma("unroll") for (int n = 0; n < 2; ++n) _Pragma("unroll") for (int k = 0; k < 2; ++k) \
        acc[ai][bj][m][n] = __builtin_amdgcn_mfma_f32_16x16x32_bf16(Bt[n][k], At[m][k], acc[ai][bj][m][n], 0, 0, 0); __builtin_amdgcn_s_setprio(0); } while (0)
#define PG8_WAIT_V(n) asm volatile("s_waitcnt vmcnt(" #n ")" ::: "memory")
#define PG8_WAIT_L(n) asm volatile("s_waitcnt lgkmcnt(" #n ")" ::: "memory")
#define PG8_BAR __builtin_amdgcn_s_barrier()
#define PG8_SCHED __builtin_amdgcn_sched_barrier(0)
#define PG8_APTR(uu) ((const char*)g.A + (size_t)(uu).pm * tstepA + (size_t)((uu).pn >> g.a_shift) * (size_t)g.a_zoff * 2)
    Unit cur, nxt; int ui = 0;
    if (!S.next(0, cur)) return;
    f32x4 acc[2][2][4][2];
#pragma unroll
    for (int a = 0; a < 2; ++a)
#pragma unroll
        for (int b = 0; b < 2; ++b)
#pragma unroll
            for (int m = 0; m < 4; ++m)
#pragma unroll
                for (int n = 0; n < 2; ++n) acc[a][b][m][n] = (f32x4){0.f, 0.f, 0.f, 0.f};
    bf16x8 At[4][2], B0[2][2], B1[2][2];
    const char* cA = PG8_APTR(cur); const char* cB = (const char*)g.Bt + (size_t)cur.pn * tstepB;
    PG8_STAGE(PG8_SB(0, 0), cB, voffB); PG8_STAGE(PG8_SB(0, 1), cB + hstepB, voffB); PG8_STAGE(PG8_SA(0, 0), cA, voffA); PG8_STAGE(PG8_SA(0, 1), cA + hstepA, voffA);
    if (wr == 1) PG8_BAR;
    PG8_WAIT_V(2); PG8_BAR;
    PG8_STAGE(PG8_SB(1, 0), cB + kstep, voffB); PG8_STAGE(PG8_SA(1, 0), cA + kstep, voffA); PG8_STAGE(PG8_SB(1, 1), cB + hstepB + kstep, voffB);
    PG8_WAIT_V(6); PG8_BAR;
    for (;;) {
        const bool has_next = S.next(ui + 1, nxt);
        const char* nA = has_next ? PG8_APTR(nxt) : cA; const char* nB = has_next ? (const char*)g.Bt + (size_t)nxt.pn * tstepB : cB;
        for (int t = 0; t < nt; t += 2) {
            const bool last = (t == nt - 2);
            const char* a1 = cA + (size_t)(t + 1) * kstep;
            const char* a2 = last ? nA : cA + (size_t)(t + 2) * kstep; const char* b2 = last ? nB : cB + (size_t)(t + 2) * kstep;
            const char* a3 = a2 + kstep; const char* b3 = b2 + kstep;
            PG8_LDB(B0, 0, 0); PG8_LDB(B1, 0, 1); PG8_SCHED; PG8_LDA(At, 0, 0); PG8_STAGE(PG8_SA(1, 1), a1 + hstepA, voffA);
            PG8_WAIT_V(8); PG8_WAIT_L(0); PG8_BAR; PG8_MMA(0, 0, At, B0); PG8_MMA(0, 1, At, B1); PG8_BAR; PG8_SCHED;
            PG8_LDA(At, 0, 1); PG8_STAGE(PG8_SB(0, 0), b2, voffB); PG8_STAGE(PG8_SB(0, 1), b2 + hstepB, voffB); PG8_STAGE(PG8_SA(0, 0), a2, voffA);
            PG8_WAIT_V(8); PG8_WAIT_L(0); PG8_BAR; PG8_MMA(1, 0, At, B0); PG8_MMA(1, 1, At, B1); PG8_BAR; PG8_SCHED;
            PG8_LDB(B0, 1, 0); PG8_LDB(B1, 1, 1); PG8_SCHED; PG8_LDA(At, 1, 0); PG8_STAGE(PG8_SA(0, 1), a2 + hstepA, voffA);
            PG8_WAIT_V(8); PG8_WAIT_L(0); PG8_BAR; PG8_MMA(0, 0, At, B0); PG8_MMA(0, 1, At, B1); PG8_BAR; PG8_SCHED;
            PG8_LDA(At, 1, 1); PG8_STAGE(PG8_SB(1, 0), b3, voffB); PG8_STAGE(PG8_SB(1, 1), b3 + hstepB, voffB); PG8_STAGE(PG8_SA(1, 0), a3, voffA);
            PG8_WAIT_V(8); PG8_WAIT_L(0); PG8_BAR; PG8_MMA(1, 0, At, B0); PG8_MMA(1, 1, At, B1); PG8_BAR; PG8_SCHED;
        }
        if constexpr (ALIGN_EPI) { if (wr == 0) PG8_BAR; }
        E(acc, cur, wr, wc, fr, fq);
        if (!has_next) break;
#pragma unroll
        for (int a = 0; a < 2; ++a)
#pragma unroll
            for (int b = 0; b < 2; ++b)
#pragma unroll
                for (int m = 0; m < 4; ++m)
#pragma unroll
                    for (int n = 0; n < 2; ++n) acc[a][b][m][n] = (f32x4){0.f, 0.f, 0.f, 0.f};
        cur = nxt; cA = nA; cB = nB; ++ui;
        if constexpr (ALIGN_EPI) { if (wr == 1) PG8_BAR; }
    }
    PG8_WAIT_V(0);
    if constexpr (!ALIGN_EPI) { if (wr == 0) PG8_BAR; }
    PG8_BAR;
#undef PG8_SA
#undef PG8_SB
#undef PG8_STAGE
#undef PG8_LDA
#undef PG8_LDB
#undef PG8_MMA
#undef PG8_WAIT_V
#undef PG8_WAIT_L
#undef PG8_BAR
#undef PG8_SCHED
#undef PG8_APTR
}
}

namespace att {
typedef unsigned short bf16_t;
typedef short bf16x8 __attribute__((ext_vector_type(8)));
typedef short s16x4 __attribute__((ext_vector_type(4)));
typedef float f32x16 __attribute__((ext_vector_type(16)));
typedef float f32x4 __attribute__((ext_vector_type(4)));
typedef unsigned u32x4 __attribute__((ext_vector_type(4)));
typedef unsigned u32x2 __attribute__((ext_vector_type(2)));
constexpr int SHM_V = 8192, SHM_K = 16384;
constexpr int OFF_V = 0, OFF_K = 2 * SHM_V, OFF_WS = OFF_K + 2 * SHM_K, OFF_TAB = OFF_WS + 2048, LDS_BYTES = OFF_TAB + 2048;
constexpr float LOG2E = 1.4426950408889634f;
constexpr float THR2 = 8.f * LOG2E;
#define SBAR() __builtin_amdgcn_sched_barrier(0)
__device__ __forceinline__ int crow(int r, int hi) { return (r & 3) + 8 * (r >> 2) + 4 * hi; }
__device__ __forceinline__ unsigned cvtpk(float lo, float hi) { unsigned r; asm volatile("v_cvt_pk_bf16_f32 %0, %1, %2" : "=v"(r) : "v"(lo), "v"(hi)); return r; }
__device__ __forceinline__ float bf_lo(unsigned w) { return __uint_as_float(w << 16); }
__device__ __forceinline__ float bf_hi(unsigned w) { return __uint_as_float(w & 0xffff0000u); }

struct UnitP {
    const bf16_t* Q; const bf16_t* K; const bf16_t* V; bf16_t* O;
    const bf16_t* K2;
    int ldq, ldk, ldv, ldo;
    int t_lo, nt;
    int q0;
    float cscale;
    float slope2, sink2;
    const float* cosT; const float* sinT;
};

template <int DQK> __device__ __forceinline__ int kaddr(int row, int chunk) {
    if (DQK == 64) return row * 128 + ((chunk ^ ((row >> 1) & 7)) << 4);
    else return row * 256 + ((chunk ^ (row & 15)) << 4);
}
__device__ __forceinline__ int v_st(int k, int c) { const int kk = (k & ~0xC) | ((k & 4) << 1) | ((k & 8) >> 1); return ((kk >> 3) * 2 + (c >> 5)) * 512 + ((kk & 7) * 32 + (c & 31)) * 2; }
__device__ __forceinline__ int v_rd_base(int lane) { return ((lane & 3) << 3) | (((lane >> 2) & 3) << 6) | (((lane >> 4) & 1) << 5) | (((lane >> 5) & 1) << 8); }
constexpr int v_rd_off(int d0, int ks, int half) { return d0 * 512 + ks * 2048 + half * 1024; }
template <int OFF> __device__ __forceinline__ s16x4 tr_read(int vb) { s16x4 r; asm volatile("ds_read_b64_tr_b16 %0, %1 offset:%2" : "=&v"(r) : "v"(vb), "i"(OFF) : "memory"); return r; }
template <int D0> __device__ __forceinline__ void pv_one(f32x16& od, int vb, bf16x8 pa0, bf16x8 pa1, bf16x8 pa2, bf16x8 pa3) {
    const s16x4 l0 = tr_read<v_rd_off(D0, 0, 0)>(vb), h0 = tr_read<v_rd_off(D0, 0, 1)>(vb), l1 = tr_read<v_rd_off(D0, 1, 0)>(vb), h1 = tr_read<v_rd_off(D0, 1, 1)>(vb);
    const s16x4 l2 = tr_read<v_rd_off(D0, 2, 0)>(vb), h2 = tr_read<v_rd_off(D0, 2, 1)>(vb), l3 = tr_read<v_rd_off(D0, 3, 0)>(vb), h3 = tr_read<v_rd_off(D0, 3, 1)>(vb);
    asm volatile("s_waitcnt lgkmcnt(0)" ::: "memory"); SBAR();
#define PK(L, H) (bf16x8){L[0], L[1], L[2], L[3], H[0], H[1], H[2], H[3]}
    od = __builtin_amdgcn_mfma_f32_32x32x16_bf16(pa0, PK(l0, h0), od, 0, 0, 0);
    od = __builtin_amdgcn_mfma_f32_32x32x16_bf16(pa1, PK(l1, h1), od, 0, 0, 0);
    od = __builtin_amdgcn_mfma_f32_32x32x16_bf16(pa2, PK(l2, h2), od, 0, 0, 0);
    od = __builtin_amdgcn_mfma_f32_32x32x16_bf16(pa3, PK(l3, h3), od, 0, 0, 0);
#undef PK
}
__device__ __forceinline__ void partialSM(f32x16& p0, f32x16& p1, float& m_reg, float& alpha) {
    float pmax = p0[0];
#pragma unroll
    for (int r = 1; r < 16; ++r) pmax = fmaxf(pmax, p0[r]);
#pragma unroll
    for (int r = 0; r < 16; ++r) pmax = fmaxf(pmax, p1[r]);
    { auto rr = __builtin_amdgcn_permlane32_swap(__float_as_uint(pmax), __float_as_uint(pmax), false, false);
      pmax = fmaxf(__uint_as_float(rr[0]), __uint_as_float(rr[1])); }
    float mn;
    if (__builtin_expect(__all(pmax - m_reg <= THR2), 1)) { mn = m_reg; alpha = 1.f; }
    else { mn = fmaxf(m_reg, pmax); alpha = __builtin_amdgcn_exp2f(m_reg - mn); m_reg = mn; }
#pragma unroll
    for (int r = 0; r < 16; ++r) p0[r] = p0[r] - mn;
#pragma unroll
    for (int r = 0; r < 16; ++r) p1[r] = p1[r] - mn;
#pragma unroll
    for (int r = 0; r < 16; ++r) p0[r] = __builtin_amdgcn_exp2f(p0[r]);
}
__device__ __forceinline__ void finishSM(f32x16& p0, f32x16& p1, float alpha, float& l_reg, bf16x8& pa0, bf16x8& pa1, bf16x8& pa2, bf16x8& pa3) {
#pragma unroll
    for (int r = 0; r < 16; ++r) p1[r] = __builtin_amdgcn_exp2f(p1[r]);
    float ps = 0;
#pragma unroll
    for (int r = 0; r < 16; ++r) ps += p0[r];
#pragma unroll
    for (int r = 0; r < 16; ++r) ps += p1[r];
    { auto rr = __builtin_amdgcn_permlane32_swap(__float_as_uint(ps), __float_as_uint(ps), false, false);
      ps = __uint_as_float(rr[0]) + __uint_as_float(rr[1]); }
    l_reg = l_reg * alpha + ps;
#define PK4(P, BASE, OUT) do { unsigned a0 = cvtpk(P[BASE + 0], P[BASE + 1]), a1 = cvtpk(P[BASE + 2], P[BASE + 3]);   \
    unsigned b0 = cvtpk(P[BASE + 4], P[BASE + 5]), b1 = cvtpk(P[BASE + 6], P[BASE + 7]);                              \
    auto r0 = __builtin_amdgcn_permlane32_swap(a0, b0, false, false); auto r1 = __builtin_amdgcn_permlane32_swap(a1, b1, false, false); \
    u32x4 w = {r0[0], r1[0], r0[1], r1[1]}; OUT = *reinterpret_cast<bf16x8*>(&w); } while (0)
    PK4(p0, 0, pa0); PK4(p0, 8, pa1); PK4(p1, 0, pa2); PK4(p1, 8, pa3);
#undef PK4
}
__device__ __forceinline__ float rowmax32(const f32x16& p0, const f32x16& p1) {
    float pmax = p0[0];
#pragma unroll
    for (int r = 1; r < 16; ++r) pmax = fmaxf(pmax, p0[r]);
#pragma unroll
    for (int r = 0; r < 16; ++r) pmax = fmaxf(pmax, p1[r]);
    auto rr = __builtin_amdgcn_permlane32_swap(__float_as_uint(pmax), __float_as_uint(pmax), false, false);
    return fmaxf(__uint_as_float(rr[0]), __uint_as_float(rr[1]));
}
template <bool FIRST> __device__ __forceinline__ void partialSM_fast(f32x16& p0, f32x16& p1, float& m_reg, f32x16& negm, float& alpha) {
    const float pmax = rowmax32(p0, p1);
    if (!FIRST && __builtin_expect(__all(pmax <= THR2), 1)) { alpha = 1.f; }
    else { const float dl = FIRST ? pmax : fmaxf(pmax, 0.f); m_reg += dl;
#pragma unroll
        for (int r = 0; r < 16; ++r) { p0[r] -= dl; p1[r] -= dl; }
#pragma unroll
        for (int r = 0; r < 16; ++r) negm[r] = -m_reg;
        alpha = __builtin_amdgcn_exp2f(-dl); }
#pragma unroll
    for (int r = 0; r < 16; ++r) p0[r] = __builtin_amdgcn_exp2f(p0[r]);
}
__device__ __forceinline__ void finishSM_fast(f32x16& p0, f32x16& p1, bf16x8& pa0, bf16x8& pa1, bf16x8& pa2, bf16x8& pa3) {
#pragma unroll
    for (int r = 0; r < 16; ++r) p1[r] = __builtin_amdgcn_exp2f(p1[r]);
#define PK4(P, BASE, OUT) do { unsigned a0 = cvtpk(P[BASE + 0], P[BASE + 1]), a1 = cvtpk(P[BASE + 2], P[BASE + 3]);   \
    unsigned b0 = cvtpk(P[BASE + 4], P[BASE + 5]), b1 = cvtpk(P[BASE + 6], P[BASE + 7]);                              \
    auto r0 = __builtin_amdgcn_permlane32_swap(a0, b0, false, false); auto r1 = __builtin_amdgcn_permlane32_swap(a1, b1, false, false); \
    u32x4 w = {r0[0], r1[0], r0[1], r1[1]}; OUT = *reinterpret_cast<bf16x8*>(&w); } while (0)
    PK4(p0, 0, pa0); PK4(p0, 8, pa1); PK4(p1, 0, pa2); PK4(p1, 8, pa3);
#undef PK4
}
__device__ __forceinline__ void pv_ones(f32x16& ol, bf16x8 pa0, bf16x8 pa1, bf16x8 pa2, bf16x8 pa3) {
    const bf16x8 ones = {0x3F80, 0x3F80, 0x3F80, 0x3F80, 0x3F80, 0x3F80, 0x3F80, 0x3F80};
    ol = __builtin_amdgcn_mfma_f32_32x32x16_bf16(pa0, ones, ol, 0, 0, 0);
    ol = __builtin_amdgcn_mfma_f32_32x32x16_bf16(pa1, ones, ol, 0, 0, 0);
    ol = __builtin_amdgcn_mfma_f32_32x32x16_bf16(pa2, ones, ol, 0, 0, 0);
    ol = __builtin_amdgcn_mfma_f32_32x32x16_bf16(pa3, ones, ol, 0, 0, 0);
}
template <int DQK> __device__ __forceinline__ void qkt_neg(f32x16& p0, f32x16& p1, const char* Ks, const bf16x8* qr, const f32x16& negm, int r32, int hi) {
#pragma unroll
    for (int d0 = 0; d0 < DQK / 16; ++d0) {
        const int a0 = kaddr<DQK>(r32, d0 * 2 + hi);
        const bf16x8 b0 = *reinterpret_cast<const bf16x8*>(Ks + a0);
        const bf16x8 b1 = *reinterpret_cast<const bf16x8*>(Ks + a0 + 32 * (DQK == 64 ? 128 : 256));
        if (d0 == 0) { p0 = __builtin_amdgcn_mfma_f32_32x32x16_bf16(b0, qr[0], negm, 0, 0, 0); p1 = __builtin_amdgcn_mfma_f32_32x32x16_bf16(b1, qr[0], negm, 0, 0, 0); }
        else { p0 = __builtin_amdgcn_mfma_f32_32x32x16_bf16(b0, qr[d0], p0, 0, 0, 0); p1 = __builtin_amdgcn_mfma_f32_32x32x16_bf16(b1, qr[d0], p1, 0, 0, 0); } }
}
template <int DQK> __device__ __forceinline__ void qkt(f32x16& p0, f32x16& p1, const char* Ks, const bf16x8* qr, int r32, int hi) {
    p0 = f32x16{}; p1 = f32x16{};
#pragma unroll
    for (int d0 = 0; d0 < DQK / 16; ++d0) {
        const int a0 = kaddr<DQK>(r32, d0 * 2 + hi);
        const bf16x8 b0 = *reinterpret_cast<const bf16x8*>(Ks + a0);
        const bf16x8 b1 = *reinterpret_cast<const bf16x8*>(Ks + a0 + 32 * (DQK == 64 ? 128 : 256));
        p0 = __builtin_amdgcn_mfma_f32_32x32x16_bf16(b0, qr[d0], p0, 0, 0, 0);
        p1 = __builtin_amdgcn_mfma_f32_32x32x16_bf16(b1, qr[d0], p1, 0, 0, 0); }
}
template <int MODE> __device__ __forceinline__ void score_fix(f32x16& p0, f32x16& p1, const UnitP& P, int tt, int wid, int r32, int hi, const float* tab) {
    const float NEG = -INFINITY;
    if (MODE == 2) {
        const int r = (P.q0 >> 6) + (wid >> 1); int c = (wid & 1) * 32 + r32; asm volatile("" : "+v"(c));
        int rs = r - 4; rs = rs < 0 ? 0 : (rs > 248 ? 248 : rs);
        int cs = c - 8; cs = cs < 0 ? 0 : (cs > 48 ? 48 : cs);
        const int kr = tt;
        if (kr < rs || kr > rs + 7) {
#pragma unroll
            for (int x = 0; x < 16; ++x) { p0[x] = NEG; p1[x] = NEG; }
        } else {
            const int ib = (kr - r + 7) * 31 + 15 - c + 4 * hi, wlo = cs - 4 * hi;
#pragma unroll
            for (int x = 0; x < 16; ++x) {
                const int kq = (x & 3) + 8 * (x >> 2);
                const int i0 = ((unsigned)(kq - wlo) < 16u) ? (ib + kq) : 465, i1 = ((unsigned)(kq + 32 - wlo) < 16u) ? (ib + kq + 32) : 465;
                p0[x] = fmaf(p0[x], P.cscale, tab[i0]); p1[x] = fmaf(p1[x], P.cscale, tab[i1]); }
        }
    } else if (MODE == 3) {
        int qpos = P.q0 + wid * 32 + r32; asm volatile("" : "+v"(qpos));
        const int kb = tt * 64, qw = P.q0 + wid * 32;
        if (kb > qw + 31 + 128 || kb + 63 < qw - 128) {
#pragma unroll
            for (int x = 0; x < 16; ++x) { p0[x] = NEG; p1[x] = NEG; }
        } else {
            const float qf = (float)(qpos - kb - 4 * hi), ns = -P.slope2;
#pragma unroll
            for (int x = 0; x < 16; ++x) {
                const float d0 = qf - (float)((x & 3) + 8 * (x >> 2)), d1 = d0 - 32.f;
                const float a0 = fabsf(d0), a1 = fabsf(d1);
                const float v0 = fmaf(a0, ns, p0[x] * P.cscale), v1 = fmaf(a1, ns, p1[x] * P.cscale);
                p0[x] = a0 <= 128.f ? v0 : NEG; p1[x] = a1 <= 128.f ? v1 : NEG; }
        }
    }
}

template <int MODE, bool NM = false>
__device__ __forceinline__ void attn_unit(const UnitP& P, char* lds) {
    constexpr int DQK = (MODE == 1) ? 96 : 64, NQ = DQK / 16, KP = (DQK == 64) ? 128 : 256;
    int tid = threadIdx.x; asm volatile("" : "+v"(tid));
    const int wid = __builtin_amdgcn_readfirstlane(tid >> 6), lane = tid & 63, r32 = lane & 31, hi = lane >> 5;
    char* V_lds = lds + OFF_V; char* K_lds = lds + OFF_K;
    float* ws = (float*)(lds + OFF_WS) + wid * 64; float* li_l = ws; float* al_l = ws + 32;
    const float* tab = (const float*)(lds + OFF_TAB);
    float m_reg = -1e30f, l_reg = 0; f32x16 o[2] = {}; bf16x8 qr[NQ];
    const bf16_t* Qw = P.Q + (size_t)(wid * 32 + r32) * P.ldq + hi * 8;
#pragma unroll
    for (int d0 = 0; d0 < NQ; ++d0) qr[d0] = *reinterpret_cast<const bf16x8*>(Qw + d0 * 16);
    if (MODE == 1) {
        const int pos = P.q0 + wid * 32 + r32;
        const f32x4 c0 = *(const f32x4*)(P.cosT + pos * 16 + hi * 8), c1 = *(const f32x4*)(P.cosT + pos * 16 + hi * 8 + 4);
        const f32x4 s0 = *(const f32x4*)(P.sinT + pos * 16 + hi * 8), s1 = *(const f32x4*)(P.sinT + pos * 16 + hi * 8 + 4);
        const float cc[8] = {c0[0], c0[1], c0[2], c0[3], c1[0], c1[1], c1[2], c1[3]}, ss[8] = {s0[0], s0[1], s0[2], s0[3], s1[0], s1[1], s1[2], s1[3]};
        const float sc = P.cscale;
#pragma unroll
        for (int d0 = 0; d0 < 4; ++d0) { u32x4 w = *reinterpret_cast<u32x4*>(&qr[d0]);
#pragma unroll
            for (int e = 0; e < 4; ++e) w[e] = cvtpk(bf_lo(w[e]) * sc, bf_hi(w[e]) * sc);
            qr[d0] = *reinterpret_cast<bf16x8*>(&w); }
        u32x4 w1 = *reinterpret_cast<u32x4*>(&qr[4]), w2 = *reinterpret_cast<u32x4*>(&qr[5]);
#pragma unroll
        for (int e = 0; e < 4; ++e) {
            const float x1a = bf_lo(w1[e]), x1b = bf_hi(w1[e]), x2a = bf_lo(w2[e]), x2b = bf_hi(w2[e]);
            const float ca = cc[2 * e], cb = cc[2 * e + 1], sa = ss[2 * e], sb = ss[2 * e + 1];
            w1[e] = cvtpk((x1a * ca - x2a * sa) * sc, (x1b * cb - x2b * sb) * sc);
            w2[e] = cvtpk((x2a * ca + x1a * sa) * sc, (x2b * cb + x1b * sb) * sc); }
        qr[4] = *reinterpret_cast<bf16x8*>(&w1); qr[5] = *reinterpret_cast<bf16x8*>(&w2);
    }
    const int srow = tid >> 3, sch = tid & 7;
    const int kst0 = kaddr<DQK>(srow, sch), kst1 = kaddr<DQK>(srow, 8 + (sch >> 1)) + (sch & 1) * 8, vst = v_st(srow, sch * 8);
    const int vb0 = (int)(uintptr_t)V_lds + v_rd_base(lane);
    const bf16_t* Kg = P.K + (size_t)srow * P.ldk + sch * 8;
    const bf16_t* Kg2 = P.K2 + (size_t)srow * 32 + sch * 4;
    const bf16_t* Vg = P.V + (size_t)srow * P.ldv + sch * 8;
    struct { u32x4 k0; u32x2 k1; u32x4 v; } sr_[2];
#define SLOAD(i, tile) do { const size_t _k = (size_t)(tile) * 64; sr_[i].k0 = *(const u32x4*)(Kg + _k * P.ldk); if (DQK == 96) sr_[i].k1 = *(const u32x2*)(Kg2 + _k * 32); \
    sr_[i].v = *(const u32x4*)(Vg + _k * P.ldv); } while (0)
#define SWRITE(b, i) do { *(u32x4*)(K_lds + (b) * SHM_K + kst0) = sr_[i].k0; if (DQK == 96) *(u32x2*)(K_lds + (b) * SHM_K + kst1) = sr_[i].k1; \
    *(u32x4*)(V_lds + (b) * SHM_V + vst) = sr_[i].v; } while (0)
#define SWAIT() do { if (DQK == 96) asm volatile("s_waitcnt vmcnt(3)" ::: "memory"); else asm volatile("s_waitcnt vmcnt(2)" ::: "memory"); } while (0)
#define RESC(a) do { if (__any((a) < 1.f)) { if (hi == 0) al_l[r32] = (a); asm volatile("s_waitcnt lgkmcnt(0)" ::: "memory"); \
    _Pragma("unroll") for (int d = 0; d < 2; ++d) _Pragma("unroll") for (int r = 0; r < 16; ++r) o[d][r] *= al_l[crow(r, hi)]; } } while (0)
#define FIX(p0, p1, tt) do { if (MODE >= 2) score_fix<MODE>(p0, p1, P, (tt), wid, r32, hi, tab); } while (0)
    f32x16 pA0, pA1, pB0, pB1; float alA, alB; bf16x8 pa0, pa1, pa2, pa3; const int NT = P.nt, T0 = P.t_lo;
    constexpr int SE = 0, SO = 1;
    constexpr bool FAST = (MODE < 2);
    f32x16 negm = {}; f32x16 ol = {};
    if (FAST) { m_reg = 0.f; asm volatile("" : "+v"(negm)); }
#define QKT(p0, p1, kb, tt) do { if (FAST) qkt_neg<DQK>(p0, p1, (kb), qr, negm, r32, hi); else { qkt<DQK>(p0, p1, (kb), qr, r32, hi); FIX(p0, p1, (tt)); } } while (0)
#define PSM(p0, p1, al) do { if (NM) { _Pragma("unroll") for (int r_ = 0; r_ < 16; ++r_) p0[r_] = __builtin_amdgcn_exp2f(p0[r_]); } else if (FAST) partialSM_fast<false>(p0, p1, m_reg, negm, al); else partialSM(p0, p1, m_reg, al); } while (0)
#define FSM(p0, p1, al) do { if (FAST) finishSM_fast(p0, p1, pa0, pa1, pa2, pa3); else finishSM(p0, p1, al, l_reg, pa0, pa1, pa2, pa3); } while (0)
#define PVT(vb) do { pv_one<0>(o[0], (vb), pa0, pa1, pa2, pa3); pv_one<1>(o[1], (vb), pa0, pa1, pa2, pa3); if (FAST) pv_ones(ol, pa0, pa1, pa2, pa3); } while (0)
#define RESC2(a) do { if (!NM && __any((a) < 1.f)) { if (hi == 0) al_l[r32] = (a); asm volatile("s_waitcnt lgkmcnt(0)" ::: "memory"); \
    _Pragma("unroll") for (int r = 0; r < 16; ++r) { const float f_ = al_l[crow(r, hi)]; o[0][r] *= f_; o[1][r] *= f_; if (FAST) ol[r] *= f_; } } } while (0)
    SLOAD(SE, T0); asm volatile("s_waitcnt vmcnt(0)" ::: "memory"); SWRITE(0, SE); __syncthreads();
    if (NM) { qkt_neg<DQK>(pA0, pA1, K_lds, qr, negm, r32, hi); PSM(pA0, pA1, alA); }
    else if (FAST) { qkt_neg<DQK>(pA0, pA1, K_lds, qr, negm, r32, hi); partialSM_fast<true>(pA0, pA1, m_reg, negm, alA); }
    else { qkt<DQK>(pA0, pA1, K_lds, qr, r32, hi); FIX(pA0, pA1, T0); partialSM(pA0, pA1, m_reg, alA); }
    SLOAD(SO, T0 + 1); if (2 < NT) SLOAD(SE, T0 + 2);
    SWAIT(); SWRITE(1, SO); __syncthreads();
    for (int j = 1; j + 1 < NT; j += 2) {
        SBAR(); QKT(pB0, pB1, K_lds + SHM_K, T0 + j);
        FSM(pA0, pA1, alA); SBAR();
        SLOAD(SO, T0 + j + 2); SBAR();
        PVT(vb0); PSM(pB0, pB1, alB);
        __syncthreads(); SWAIT(); SWRITE(0, SE);
        RESC2(alB); __syncthreads();
        SBAR(); QKT(pA0, pA1, K_lds, T0 + j + 1);
        FSM(pB0, pB1, alB); SBAR();
        if (j + 3 < NT) SLOAD(SE, T0 + j + 3); SBAR();
        PVT(vb0 + SHM_V); PSM(pA0, pA1, alA);
        __syncthreads(); SWAIT(); SWRITE(1, SO);
        RESC2(alA); __syncthreads();
    }
    SBAR(); QKT(pB0, pB1, K_lds + SHM_K, T0 + NT - 1);
    FSM(pA0, pA1, alA); SBAR();
    PVT(vb0); PSM(pB0, pB1, alB);
    __syncthreads(); RESC2(alB);
    FSM(pB0, pB1, alB); SBAR();
    PVT(vb0 + SHM_V);
    float rli[16];
    if (FAST) {
#pragma unroll
        for (int r = 0; r < 16; ++r) rli[r] = __builtin_amdgcn_rcpf(ol[r]);
    } else {
        if (MODE == 3) l_reg += __builtin_amdgcn_exp2f(P.sink2 - m_reg);
        if (hi == 0) li_l[r32] = l_reg; asm volatile("s_waitcnt lgkmcnt(0)" ::: "memory");
#pragma unroll
        for (int r = 0; r < 16; ++r) rli[r] = __builtin_amdgcn_rcpf(li_l[crow(r, hi)]);
    }
    bf16_t* Ow = P.O + (size_t)(wid * 32) * P.ldo;
#pragma unroll
    for (int r = 0; r < 16; ++r) { const int orow = crow(r, hi);
#pragma unroll
        for (int d0 = 0; d0 < 2; ++d0) { const unsigned w = cvtpk(o[d0][r] * rli[r], 0.f); Ow[(size_t)orow * P.ldo + d0 * 32 + r32] = (bf16_t)(w & 0xffffu); } }
#undef QKT
#undef PSM
#undef FSM
#undef PVT
#undef RESC2
    __syncthreads();
#undef SLOAD
#undef SWRITE
#undef SWAIT
#undef RESC
#undef FIX
}
#undef SBAR
}

typedef unsigned short bf16;
typedef float f32x4 __attribute__((ext_vector_type(4)));
typedef unsigned u32x4 __attribute__((ext_vector_type(4)));
typedef unsigned u32x2 __attribute__((ext_vector_type(2)));
#define LAS __attribute__((address_space(3)))

constexpr int T_TOK = 32768, SEQ = 16384, DM = 1024, FF = 4096, INW = 2144, INWP = 2304, DEPTH = 2;
constexpr float EPS = 1e-6f;
constexpr size_t MiB = 1u << 20;
constexpr size_t WS_COS = 1 * MiB, WS_SIN = 2 * MiB, WS_W = 4 * MiB, W_LAYER = 34 * MiB;
constexpr size_t WO_IN = 0, WO_G = WO_IN + (size_t)INWP * 1024 * 2, WO_D = WO_G + (size_t)4096 * 1024 * 2, WO_B = WO_D + (size_t)1024 * 384 * 2,
                 WO_O = WO_B + (size_t)4096 * 256 * 2, WO_1 = WO_O + (size_t)1024 * 1024 * 2, WO_2 = WO_1 + (size_t)4096 * 1024 * 2, WO_END = WO_2 + (size_t)4096 * 1024 * 2;
static_assert(WO_END <= W_LAYER, "weight map");
constexpr size_t WS_H = 72 * MiB, WS_BR = 136 * MiB, WS_BIG = 200 * MiB, WS_END = 456 * MiB;
constexpr size_t BIG_QKV = 0, BIG_DA = 144 * MiB, BIG_DX = 168 * MiB, BIG_KR = 232 * MiB;
constexpr int LDS_TOTAL = 147456;

#ifndef EN_MASK
#define EN_MASK 0xffff
#endif
#define EN(k) ((EN_MASK >> (k)) & 1)
#ifndef ATT_MASK
#define ATT_MASK 0xf
#endif
#define AEN(k) ((ATT_MASK >> (k)) & 1)
struct Params { const float* in[19]; float* out; unsigned char* ws; int ph_lo, ph_hi; };
constexpr int PAR_OFF = 139264;
__device__ __forceinline__ unsigned long long par_get(LAS unsigned char* lds, int i) {
    volatile LAS unsigned* pp = (volatile LAS unsigned*)(lds + PAR_OFF) + 2 * i;
    const unsigned lo = __builtin_amdgcn_readfirstlane(pp[0]), hi = __builtin_amdgcn_readfirstlane(pp[1]);
    return ((unsigned long long)hi << 32) | lo;
}
#define PIN(i) (kp.in[(i)])
#define PWS() (kp.ws)
#define POUT() (kp.out)

__device__ __forceinline__ unsigned f2bf(float f) { unsigned u = __builtin_bit_cast(unsigned, f); return (u + 0x7fffu + ((u >> 16) & 1u)) >> 16; }
__device__ __forceinline__ unsigned pk2(float lo, float hi) { return f2bf(lo) | (f2bf(hi) << 16); }
__device__ __forceinline__ float bflo(unsigned w) { return __uint_as_float(w << 16); }
__device__ __forceinline__ float bfhi(unsigned w) { return __uint_as_float(w & 0xffff0000u); }
__device__ __forceinline__ float wave_sum(float v) {
#pragma unroll
    for (int o = 1; o < 64; o <<= 1) v += __shfl_xor(v, o);
    return v;
}


#define XB_TMO      128
#define XB_XCNT(j)  (256  + 64 * (j))
#define XB_XSUB(j)  (1280 + 64 * (j))
#define XB_XGEN(j)  (2304 + 64 * (j))
#define XB_TOP      3328
#define XB_TOPGEN   3392
#define XCD_BAR_WORDS 3456
#define XB_SPIN_CAP (1u << 18)
__device__ __forceinline__ unsigned xb_ld(unsigned* p)              { return __hip_atomic_load(p, __ATOMIC_RELAXED, __HIP_MEMORY_SCOPE_AGENT); }
__device__ __forceinline__ unsigned xb_add(unsigned* p, unsigned v) { return __hip_atomic_fetch_add(p, v, __ATOMIC_RELAXED, __HIP_MEMORY_SCOPE_AGENT); }
__device__ __forceinline__ unsigned xb_xcc_id() { return (unsigned)__builtin_amdgcn_s_getreg((3 << 11) | 20) & 0xFu; }
#define XB_SPIN(cond, bar) do { unsigned _sp = 0; while (cond) { __builtin_amdgcn_s_sleep(1); \
    if ((++_sp & 255u) == 0u) { if (xb_ld(&(bar)[XB_TMO])) break; if (_sp > XB_SPIN_CAP) { atomicAdd(&(bar)[XB_TMO], 1u); break; } } } } while (0)
struct XcdBarrier { unsigned* bar; unsigned x; volatile LAS unsigned* st; };
__device__ __forceinline__ XcdBarrier xcd_barrier_post(unsigned* bar, volatile LAS unsigned* st) {
    XcdBarrier b; b.bar = bar; b.x = xb_xcc_id(); b.st = st;
    if (threadIdx.x == 0) (void)xb_add(&bar[XB_XCNT(b.x)], 1u);
    return b;
}
__device__ __forceinline__ void xcd_barrier_complete(unsigned* bar, unsigned x, unsigned& nloc, unsigned& nx) {
    const unsigned G = gridDim.x * gridDim.y * gridDim.z;
    unsigned sum, cnt, mine, sp = 0u;
    for (;;) {
        sum = 0u; cnt = 0u; mine = 0u;
#pragma unroll
        for (unsigned j = 0; j < 16; ++j) { const unsigned c = xb_ld(&bar[XB_XCNT(j)]); sum += c; cnt += (c > 0u) ? 1u : 0u; mine = (j == x) ? c : mine; }
        if (sum == G) break;
        __builtin_amdgcn_s_sleep(1);
        if ((++sp & 255u) == 0u) { if (xb_ld(&bar[XB_TMO])) break; if (sp > XB_SPIN_CAP) { atomicAdd(&bar[XB_TMO], 1u); break; } }
    }
    nloc = mine > 0u ? mine : 1u; nx = cnt > 0u ? cnt : 1u;
}
__device__ __forceinline__ void xcd_barrier(const XcdBarrier& b) {
    asm volatile("s_waitcnt vmcnt(0)" ::: "memory");
    __syncthreads();
    if (threadIdx.x == 0) {
        unsigned* bar = b.bar;
        __builtin_amdgcn_s_waitcnt(0);
        unsigned nloc = b.st[0], nx = b.st[1];
        if (nloc == 0u) { xcd_barrier_complete(bar, b.x, nloc, nx); b.st[0] = nloc; b.st[1] = nx; }
        const unsigned old = xb_add(&bar[XB_XSUB(b.x)], 1u);
        const unsigned gen = old / nloc;
        if (old + 1u == (gen + 1u) * nloc) {
            __builtin_amdgcn_fence(__ATOMIC_RELEASE, "agent");
            asm volatile("s_waitcnt vmcnt(0)" ::: "memory");
            const unsigned og = xb_add(&bar[XB_TOP], 1u);
            const unsigned tg = og / nx;
            if (og + 1u == (tg + 1u) * nx) xb_add(&bar[XB_TOPGEN], 1u);
            else XB_SPIN(xb_ld(&bar[XB_TOPGEN]) == tg, bar);
            __builtin_amdgcn_fence(__ATOMIC_ACQUIRE, "agent");
            xb_add(&bar[XB_XGEN(b.x)], 1u);
            asm volatile("s_waitcnt vmcnt(0)" ::: "memory");
        } else {
            XB_SPIN(xb_ld(&bar[XB_XGEN(b.x)]) == gen, bar);
            __builtin_amdgcn_fence(__ATOMIC_ACQUIRE, "agent");
            asm volatile("s_waitcnt vmcnt(0)" ::: "memory");
        }
    }
    __syncthreads();
}

template <bool GATE>
__device__ __forceinline__ void tr_item(const float* src, int ldsrc, int k0s, int n0s, bf16* dst, int lddst, int k0d, int n0d, LAS float* scr, int lane) {
#pragma unroll 8
    for (int i = 0; i < 32; ++i) { const int kk = 2 * i + (lane >> 5); scr[kk * 33 + (lane & 31)] = src ? src[(size_t)(k0s + kk) * ldsrc + n0s + (lane & 31)] : 0.f; }
    asm volatile("s_waitcnt lgkmcnt(0)" ::: "memory");
    const int c = lane & 7;
#pragma unroll
    for (int j = 0; j < 4; ++j) { const int n = (lane >> 3) + 8 * j; const LAS float* s = scr + (8 * c) * 33 + n;
        u32x4 o; o.x = pk2(s[0 * 33], s[1 * 33]); o.y = pk2(s[2 * 33], s[3 * 33]); o.z = pk2(s[4 * 33], s[5 * 33]); o.w = pk2(s[6 * 33], s[7 * 33]);
        int drow = n0d + n;
        if (GATE) { const int nb = drow >> 10, d = drow & 1023, dl = d & 63; drow = (d >> 6) * 256 + 128 * (nb >> 1) + 32 * (dl >> 4) + 8 * ((dl >> 2) & 3) + 4 * (nb & 1) + (dl & 3); }
        *(u32x4*)(dst + (size_t)drow * lddst + k0d + 8 * c) = o; }
    asm volatile("s_waitcnt lgkmcnt(0)" ::: "memory");
}

__device__ __forceinline__ void phase_prologue(const Params& kp, LAS unsigned char* lds, int gw, int NGW, int wave, int lane) {
    asm volatile("" : "+v"(lane)); asm volatile("" : "+s"(gw));
    asm volatile("" : "+s"(wave));
    unsigned char* const ws_ = PWS();
    LAS float* scr = (LAS float*)(lds + wave * 16384);
    constexpr int I_IN = 16 * 67, I_INZ = 16 * 5, I_G = 16 * 128, I_D = 6 * 32, I_B = 4 * 4 * 32, I_O = 16 * 32, I_1 = 16 * 128, I_2 = 64 * 32;
    constexpr int PER = I_IN + I_INZ + I_G + I_D + I_B + I_O + I_1 + I_2;
    for (int it = gw; it < DEPTH * PER; it += NGW) {
        const int l = it / PER; int r = it % PER;
        unsigned char* wb = ws_ + WS_W + (size_t)l * W_LAYER;
        if (r < I_IN) { const int kb = r / 67, nb = r % 67; tr_item<false>(PIN(2) + (size_t)l * 1024 * INW, INW, kb * 64, nb * 32, (bf16*)(wb + WO_IN), 1024, kb * 64, nb * 32, scr, lane); continue; } r -= I_IN;
        if (r < I_INZ) { const int kb = r / 5, nb = r % 5; tr_item<false>(nullptr, 0, 0, 0, (bf16*)(wb + WO_IN), 1024, kb * 64, INW + nb * 32, scr, lane); continue; } r -= I_INZ;
        if (r < I_G) { const int kb = r / 128, nb = r % 128; tr_item<true>(PIN(3) + (size_t)l * 1024 * 4096, 4096, kb * 64, nb * 32, (bf16*)(wb + WO_G), 1024, kb * 64, nb * 32, scr, lane); continue; } r -= I_G;
        if (r < I_D) { const int kb = r / 32, nb = r % 32; const float* src = nullptr; int ld = 0, k0 = 0, n0 = 0;
            if (nb < 12 && kb < 3) { src = PIN(11) + (size_t)l * 192 * 384; ld = 384; k0 = kb * 64; n0 = nb * 32; }
            else if (nb >= 12 && nb < 28 && (kb == 3 || kb == 4)) { src = PIN(12) + (size_t)l * 128 * 512; ld = 512; k0 = (kb - 3) * 64; n0 = (nb - 12) * 32; }
            tr_item<false>(src, ld, k0, n0, (bf16*)(wb + WO_D), 384, kb * 64, nb * 32, scr, lane); continue; } r -= I_D;
        if (r < I_B) { const int n = r / 128, q = r % 128, kb = q / 32, nb = q % 32;
            tr_item<false>(PIN(13) + ((size_t)l * 4 + n) * 256 * 1024, 1024, kb * 64, nb * 32, (bf16*)(wb + WO_B), 256, kb * 64, n * 1024 + nb * 32, scr, lane); continue; } r -= I_B;
        if (r < I_O) { const int kb = r / 32, nb = r % 32; tr_item<false>(PIN(14) + (size_t)l * 1024 * 1024, 1024, kb * 64, nb * 32, (bf16*)(wb + WO_O), 1024, kb * 64, nb * 32, scr, lane); continue; } r -= I_O;
        if (r < I_1) { const int kb = r / 128, nb = r % 128; tr_item<false>(PIN(16) + (size_t)l * 1024 * 4096, 4096, kb * 64, nb * 32, (bf16*)(wb + WO_1), 1024, kb * 64, nb * 32, scr, lane); continue; } r -= I_1;
        { const int kb = r / 32, nb = r % 32; tr_item<false>(PIN(17) + (size_t)l * 4096 * 1024, 1024, kb * 64, nb * 32, (bf16*)(wb + WO_2), 4096, kb * 64, nb * 32, scr, lane); }
    }
    const float inv[16] = {1.000000000e+00f, 5.623413324e-01f, 3.162277639e-01f, 1.778279394e-01f, 1.000000015e-01f, 5.623413250e-02f, 3.162277490e-02f, 1.778279431e-02f,
                           9.999999776e-03f, 5.623413250e-03f, 3.162277630e-03f, 1.778279431e-03f, 1.000000047e-03f, 5.623413017e-04f, 3.162277571e-04f, 1.778279402e-04f};
    float* cosT = (float*)(ws_ + WS_COS); float* sinT = (float*)(ws_ + WS_SIN);
    for (int idx = gw * 64 + lane; idx < SEQ * 16; idx += NGW * 64) {
        const int pos = idx >> 4, i = idx & 15;
        float iv = inv[0];
#pragma unroll
        for (int q = 1; q < 16; ++q) iv = (i == q) ? inv[q] : iv;
        const float angf = (float)pos * iv;
        const double a = (double)angf;
        const double kq = __builtin_rint(a * 0.15915494309189535);
        double rr = __builtin_fma(-kq, 6.283185307179586, a); rr = __builtin_fma(-kq, 2.4492935982947064e-16, rr);
        const double r2 = rr * rr;
        double sp = -1.0 / 1.0888869450418352e28, cp = 1.0 / 4.0329146112660565e26;
        const double fs[13] = {1.0 / 1.5511210043330986e25, -1.0 / 2.5852016738884978e22, 1.0 / 5.109094217170944e19, -1.0 / 1.21645100408832e17, 1.0 / 3.55687428096e14,
                               -1.0 / 1.307674368e12, 1.0 / 6.2270208e9, -1.0 / 3.99168e7, 1.0 / 3.6288e5, -1.0 / 5.04e3, 1.0 / 1.2e2, -1.0 / 6.0, 1.0};
        const double fc[13] = {-1.0 / 6.204484017332394e23, 1.0 / 1.1240007277776077e21, -1.0 / 2.43290200817664e18, 1.0 / 6.402373705728e15, -1.0 / 2.0922789888e13,
                               1.0 / 8.71782912e10, -1.0 / 4.790016e8, 1.0 / 3.6288e6, -1.0 / 4.032e4, 1.0 / 7.2e2, -1.0 / 2.4e1, 1.0 / 2.0, -1.0};
#pragma unroll
        for (int q = 0; q < 13; ++q) { sp = __builtin_fma(sp, r2, fs[q]); cp = __builtin_fma(cp, r2, fc[q]); }
        cosT[idx] = (float)(-cp); sinT[idx] = (float)(sp * rr);
    }
}

__device__ __forceinline__ void phase_norm(const float* __restrict__ x, const float* __restrict__ g, bf16* __restrict__ out, int gw, int NGW, int lane) {
    asm volatile("" : "+v"(lane)); asm volatile("" : "+s"(gw));
    f32x4 gv[4];
#pragma unroll
    for (int j = 0; j < 4; ++j) gv[j] = ((const f32x4*)g)[lane + 64 * j];
    for (int m = gw; m < T_TOK; m += 2 * NGW) {
        const int m2 = m + NGW;
        const f32x4* xr = (const f32x4*)(x + (size_t)m * DM) + lane;
        const f32x4* xr2 = (const f32x4*)(x + (size_t)(m2 < T_TOK ? m2 : m) * DM) + lane;
        f32x4 v[4], w[4]; float s = 0.f, s2 = 0.f;
#pragma unroll
        for (int j = 0; j < 4; ++j) { v[j] = xr[64 * j]; w[j] = xr2[64 * j]; }
#pragma unroll
        for (int j = 0; j < 4; ++j) { s += (v[j].x * v[j].x + v[j].y * v[j].y) + (v[j].z * v[j].z + v[j].w * v[j].w); s2 += (w[j].x * w[j].x + w[j].y * w[j].y) + (w[j].z * w[j].z + w[j].w * w[j].w); }
        const float rstd = 1.0f / sqrtf(wave_sum(s) * (1.f / DM) + EPS), rstd2 = 1.0f / sqrtf(wave_sum(s2) * (1.f / DM) + EPS);
        u32x2* o8 = (u32x2*)(out + (size_t)m * DM) + lane;
#pragma unroll
        for (int j = 0; j < 4; ++j) { u32x2 q; q.x = pk2(v[j].x * rstd * gv[j].x, v[j].y * rstd * gv[j].y); q.y = pk2(v[j].z * rstd * gv[j].z, v[j].w * rstd * gv[j].w); o8[64 * j] = q; }
        if (m2 < T_TOK) { u32x2* o82 = (u32x2*)(out + (size_t)m2 * DM) + lane;
#pragma unroll
            for (int j = 0; j < 4; ++j) { u32x2 q; q.x = pk2(w[j].x * rstd2 * gv[j].x, w[j].y * rstd2 * gv[j].y); q.y = pk2(w[j].z * rstd2 * gv[j].z, w[j].w * rstd2 * gv[j].w); o82[64 * j] = q; } }
    }
}
__device__ __forceinline__ void phase_norm_bf(const bf16* __restrict__ x, const float* __restrict__ g, bf16* __restrict__ out, int gw, int NGW, int lane) {
    asm volatile("" : "+v"(lane)); asm volatile("" : "+s"(gw));
    f32x4 gv[2][2];
#pragma unroll
    for (int j = 0; j < 2; ++j) { gv[j][0] = *(const f32x4*)(g + 8 * lane + 512 * j); gv[j][1] = *(const f32x4*)(g + 8 * lane + 512 * j + 4); }
    for (int m = gw; m < T_TOK; m += 2 * NGW) {
        const int m2 = (m + NGW) < T_TOK ? (m + NGW) : m;
        u32x4 a[2], b[2];
#pragma unroll
        for (int j = 0; j < 2; ++j) { a[j] = *(const u32x4*)(x + (size_t)m * DM + 8 * lane + 512 * j); b[j] = *(const u32x4*)(x + (size_t)m2 * DM + 8 * lane + 512 * j); }
        float s1 = 0.f, s2 = 0.f;
#pragma unroll
        for (int j = 0; j < 2; ++j)
#pragma unroll
            for (int e = 0; e < 4; ++e) { const float p = bflo(a[j][e]), q = bfhi(a[j][e]), r = bflo(b[j][e]), t = bfhi(b[j][e]); s1 += p * p + q * q; s2 += r * r + t * t; }
        const float rs1 = 1.0f / sqrtf(wave_sum(s1) * (1.f / DM) + EPS), rs2 = 1.0f / sqrtf(wave_sum(s2) * (1.f / DM) + EPS);
#pragma unroll
        for (int j = 0; j < 2; ++j) { u32x4 w1, w2;
#pragma unroll
            for (int e = 0; e < 4; ++e) { const float g0 = gv[j][e >> 1][(e & 1) * 2], g1 = gv[j][e >> 1][(e & 1) * 2 + 1];
                w1[e] = pk2(bflo(a[j][e]) * rs1 * g0, bfhi(a[j][e]) * rs1 * g1); w2[e] = pk2(bflo(b[j][e]) * rs2 * g0, bfhi(b[j][e]) * rs2 * g1); }
            *(u32x4*)(out + (size_t)m * DM + 8 * lane + 512 * j) = w1;
            if (m2 != m) *(u32x4*)(out + (size_t)m2 * DM + 8 * lane + 512 * j) = w2; }
    }
}
__device__ __forceinline__ void phase_final_norm(const bf16* __restrict__ x, const float* __restrict__ g, float* __restrict__ out, int gw, int NGW, int lane) {
    asm volatile("" : "+v"(lane)); asm volatile("" : "+s"(gw));
    f32x4 gv[2][2];
#pragma unroll
    for (int j = 0; j < 2; ++j) { gv[j][0] = *(const f32x4*)(g + 8 * lane + 512 * j); gv[j][1] = *(const f32x4*)(g + 8 * lane + 512 * j + 4); }
    for (int m = gw; m < T_TOK; m += 2 * NGW) {
        const int m2 = (m + NGW) < T_TOK ? (m + NGW) : m;
        u32x4 a[2], b[2];
#pragma unroll
        for (int j = 0; j < 2; ++j) { a[j] = *(const u32x4*)(x + (size_t)m * DM + 8 * lane + 512 * j); b[j] = *(const u32x4*)(x + (size_t)m2 * DM + 8 * lane + 512 * j); }
        float s1 = 0.f, s2 = 0.f;
#pragma unroll
        for (int j = 0; j < 2; ++j)
#pragma unroll
            for (int e = 0; e < 4; ++e) { const float p = bflo(a[j][e]), q = bfhi(a[j][e]), r = bflo(b[j][e]), t = bfhi(b[j][e]); s1 += p * p + q * q; s2 += r * r + t * t; }
        const float rs1 = 1.0f / sqrtf(wave_sum(s1) * (1.f / DM) + EPS), rs2 = 1.0f / sqrtf(wave_sum(s2) * (1.f / DM) + EPS);
#pragma unroll
        for (int j = 0; j < 2; ++j) {
            float* o1 = out + (size_t)m * DM + 8 * lane + 512 * j; float* o2 = out + (size_t)m2 * DM + 8 * lane + 512 * j;
            const f32x4 x0 = (f32x4){bflo(a[j][0]), bfhi(a[j][0]), bflo(a[j][1]), bfhi(a[j][1])}, x1 = (f32x4){bflo(a[j][2]), bfhi(a[j][2]), bflo(a[j][3]), bfhi(a[j][3])};
            const f32x4 y0 = (f32x4){bflo(b[j][0]), bfhi(b[j][0]), bflo(b[j][1]), bfhi(b[j][1])}, y1 = (f32x4){bflo(b[j][2]), bfhi(b[j][2]), bflo(b[j][3]), bfhi(b[j][3])};
            *(f32x4*)o1 = x0 * rs1 * gv[j][0]; *(f32x4*)(o1 + 4) = x1 * rs1 * gv[j][1];
            if (m2 != m) { *(f32x4*)o2 = y0 * rs2 * gv[j][0]; *(f32x4*)(o2 + 4) = y1 * rs2 * gv[j][1]; } }
    }
}

__device__ __forceinline__ void phase_prep(const Params& kp, LAS unsigned char* lds, int l, int gw, int NGW, int lane) {
    asm volatile("" : "+v"(lane)); asm volatile("" : "+s"(gw));
    unsigned char* const ws_ = PWS();
    bf16* QKV = (bf16*)(ws_ + WS_BIG + BIG_QKV); bf16* DA = (bf16*)(ws_ + WS_BIG + BIG_DA); bf16* KR = (bf16*)(ws_ + WS_BIG + BIG_KR);
    const float* cosT = (const float*)(ws_ + WS_COS); const float* sinT = (const float*)(ws_ + WS_SIN);
    const float* gq = PIN(5) + l * 64; const float* gk = PIN(6) + l * 64; const float* gdq = PIN(9) + l * 192; const float* gdkv = PIN(10) + l * 128;
    const int m16 = lane & 15;
    const f32x4 gq4 = *(const f32x4*)(gq + m16 * 4), gk4 = *(const f32x4*)(gk + m16 * 4);
    const f32x4 gdq4 = lane < 48 ? *(const f32x4*)(gdq + lane * 4) : (f32x4){0.f, 0.f, 0.f, 0.f};
    const f32x4 gdkv4 = lane < 32 ? *(const f32x4*)(gdkv + lane * 4) : (f32x4){0.f, 0.f, 0.f, 0.f};
    const float CA = 0.125f * 1.4426950408889634f;
    for (int t = gw; t < T_TOK; t += NGW) {
        bf16* row = QKV + (size_t)t * INWP;
        const int tin = t & (SEQ - 1), prow = tin >> 6, pcol = tin & 63;
        const int blk = m16 >> 3, i0 = (m16 & 7) * 4, ti = i0 & 15; const bool isx2 = i0 >= 16;
        const int posA = blk ? pcol : prow;
        const u32x2 wq = *(const u32x2*)(row + 4 * lane);
        const u32x2 wk = lane < 32 ? *(const u32x2*)(row + 256 + 4 * lane) : (u32x2){0u, 0u};
        const u32x2 wcq = lane < 48 ? *(const u32x2*)(row + 1792 + 4 * lane) : (u32x2){0u, 0u};
        const u32x2 wckv = lane < 32 ? *(const u32x2*)(row + 1984 + 4 * lane) : (u32x2){0u, 0u};
        const u32x2 wkr = lane < 8 ? *(const u32x2*)(row + 2112 + 4 * lane) : (u32x2){0u, 0u};
        const f32x4 cA = *(const f32x4*)(cosT + posA * 16 + ti), sA = *(const f32x4*)(sinT + posA * 16 + ti);
        const f32x4 cD = *(const f32x4*)(cosT + tin * 16 + ti), sD = *(const f32x4*)(sinT + tin * 16 + ti);
#pragma unroll
        for (int pass = 0; pass < 2; ++pass) {
            const bool act = (pass == 0) || (lane < 32);
            bf16* ptr = row + pass * 256 + 4 * lane;
            const u32x2 w = pass == 0 ? wq : wk;
            float x[4] = {bflo(w.x), bfhi(w.x), bflo(w.y), bfhi(w.y)};
            float ss = (x[0] * x[0] + x[1] * x[1]) + (x[2] * x[2] + x[3] * x[3]);
            ss += __shfl_xor(ss, 1); ss += __shfl_xor(ss, 2); ss += __shfl_xor(ss, 4); ss += __shfl_xor(ss, 8);
            const float rstd = 1.0f / sqrtf(ss * (1.f / 64.f) + EPS);
            const f32x4 g4 = pass == 0 ? gq4 : gk4;
            float y[4], o[4];
#pragma unroll
            for (int e = 0; e < 4; ++e) y[e] = x[e] * rstd * g4[e];
#pragma unroll
            for (int e = 0; e < 4; ++e) { const float pr = __shfl_xor(y[e], 4); o[e] = isx2 ? (y[e] * cA[e] + pr * sA[e]) : (y[e] * cA[e] - pr * sA[e]); if (pass == 0) o[e] *= CA; }
            if (act) { u32x2 ow; ow.x = pk2(o[0], o[1]); ow.y = pk2(o[2], o[3]); *(u32x2*)ptr = ow; }
        }
        {
            float x[4] = {bflo(wcq.x), bfhi(wcq.x), bflo(wcq.y), bfhi(wcq.y)};
            const float ss = wave_sum((x[0] * x[0] + x[1] * x[1]) + (x[2] * x[2] + x[3] * x[3]));
            const float rstd = 1.0f / sqrtf(ss * (1.f / 192.f) + EPS);
            if (lane < 48) { u32x2 ow; ow.x = pk2(x[0] * rstd * gdq4[0], x[1] * rstd * gdq4[1]); ow.y = pk2(x[2] * rstd * gdq4[2], x[3] * rstd * gdq4[3]); *(u32x2*)(DA + (size_t)t * 384 + 4 * lane) = ow; }
        }
        {
            float x[4] = {bflo(wckv.x), bfhi(wckv.x), bflo(wckv.y), bfhi(wckv.y)};
            const float ss = wave_sum((x[0] * x[0] + x[1] * x[1]) + (x[2] * x[2] + x[3] * x[3]));
            const float rstd = 1.0f / sqrtf(ss * (1.f / 128.f) + EPS);
            u32x2 ow; ow.x = pk2(x[0] * rstd * gdkv4[0], x[1] * rstd * gdkv4[1]); ow.y = pk2(x[2] * rstd * gdkv4[2], x[3] * rstd * gdkv4[3]);
            if (lane >= 32) { ow.x = 0u; ow.y = 0u; }
            if (lane < 48) *(u32x2*)(DA + (size_t)t * 384 + 192 + 4 * lane) = ow;
        }
        {
            float x[4] = {bflo(wkr.x), bfhi(wkr.x), bflo(wkr.y), bfhi(wkr.y)};
            float o[4];
#pragma unroll
            for (int e = 0; e < 4; ++e) { const float pr = __shfl_xor(x[e], 4); o[e] = isx2 ? (x[e] * cD[e] + pr * sD[e]) : (x[e] * cD[e] - pr * sD[e]); }
            if (lane < 8) { u32x2 ow; ow.x = pk2(o[0], o[1]); ow.y = pk2(o[2], o[3]); *(u32x2*)(KR + (size_t)t * 32 + 4 * lane) = ow; }
        }
    }
}

__device__ __forceinline__ void phase_attention(const Params& kp, LAS unsigned char* lds, int l, char* ldsg, int vcu, int G) {
    asm volatile("" : "+s"(vcu));
    unsigned char* const ws_ = PWS();
    const bf16* QKV = (const bf16*)(ws_ + WS_BIG + BIG_QKV); const bf16* DX = (const bf16*)(ws_ + WS_BIG + BIG_DX); const bf16* KR = (const bf16*)(ws_ + WS_BIG + BIG_KR);
    bf16* BR = (bf16*)(ws_ + WS_BR);
    const int upc = (512 + G - 1) / G, u0 = vcu * upc, u1 = (u0 + upc) < 512 ? (u0 + upc) : 512;
    const float L2E = 1.4426950408889634f;
    att::UnitP P;
    P.cosT = (const float*)(ws_ + WS_COS); P.sinT = (const float*)(ws_ + WS_SIN); P.slope2 = 0.f; P.sink2 = 0.f; P.cscale = 1.f; P.K2 = nullptr;
    bool nomaxA;
    { const int ln = threadIdx.x & 63; float gq = fabsf(PIN(5)[l * 64 + ln]), gk = fabsf(PIN(6)[l * 64 + ln]);
#pragma unroll
      for (int o_ = 1; o_ < 64; o_ <<= 1) { gq = fmaxf(gq, __shfl_xor(gq, o_)); gk = fmaxf(gk, __shfl_xor(gk, o_)); }
      const float bound2 = 8.f * gq * gk * L2E * 1.02f;
      nomaxA = __builtin_amdgcn_readfirstlane(bound2 <= 40.f ? 1 : 0) != 0; }
    if (AEN(0)) for (int u = u0; u < u1; ++u) { const int bh = u >> 6, qb = u & 63, b = bh >> 2, h = bh & 3; const size_t r0 = (size_t)b * SEQ;
        P.Q = QKV + (r0 + qb * 256) * INWP + h * 64; P.K = QKV + r0 * INWP + 256 + (h >> 1) * 64; P.V = QKV + r0 * INWP + 384 + (h >> 1) * 64; P.O = BR + (r0 + qb * 256) * 1024 + h * 64;
        P.ldq = INWP; P.ldk = INWP; P.ldv = INWP; P.ldo = 1024; P.t_lo = 0; P.nt = 256; P.q0 = qb * 256;
        if (nomaxA) att::attn_unit<0, true>(P, ldsg); else att::attn_unit<0, false>(P, ldsg); }
    if (AEN(1)) for (int u = u0; u < u1; ++u) { const int bh = u >> 6, qb = u & 63, b = bh >> 2, h = bh & 3; const size_t r0 = (size_t)b * SEQ;
        P.Q = DX + (r0 + qb * 256) * 1024 + h * 96; P.K = DX + r0 * 1024 + 384 + h * 128; P.V = DX + r0 * 1024 + 384 + h * 128 + 64; P.K2 = KR + r0 * 32; P.O = BR + (r0 + qb * 256) * 1024 + 768 + h * 64;
        P.ldq = 1024; P.ldk = 1024; P.ldv = 1024; P.ldo = 1024; P.t_lo = 0; P.nt = 256; P.q0 = qb * 256; P.cscale = 0.10206207261596575f * L2E;
        att::attn_unit<1>(P, ldsg); }
    if (AEN(3)) for (int u = u0; u < u1; ++u) { const int bh = u >> 6, qb = u & 63, b = bh >> 2, h = bh & 3; const size_t r0 = (size_t)b * SEQ;
        P.Q = QKV + (r0 + qb * 256) * INWP + 1280 + h * 64; P.K = QKV + r0 * INWP + 1536 + (h >> 1) * 64; P.V = QKV + r0 * INWP + 1664 + (h >> 1) * 64; P.O = BR + (r0 + qb * 256) * 1024 + 512 + h * 64;
        P.ldq = INWP; P.ldk = INWP; P.ldv = INWP; P.ldo = 1024; P.q0 = qb * 256;
        int lo = qb * 4 - 2, hi = qb * 4 + 6; lo = lo < 0 ? 0 : lo; hi = hi > 256 ? 256 : hi; P.t_lo = lo; P.nt = hi - lo;
        P.cscale = 0.125f * L2E; P.slope2 = __builtin_amdgcn_exp2f(-2.f * (float)(h + 1)) * L2E; P.sink2 = PIN(8)[l * 4 + h] * L2E;
        att::attn_unit<3>(P, ldsg); }
    if (AEN(2)) for (int u = u0; u < u1; ++u) { const int bh = u >> 6, qb = u & 63, b = bh >> 2, h = bh & 3; const size_t r0 = (size_t)b * SEQ;
        { float* tab = (float*)(ldsg + att::OFF_TAB); const float* src = PIN(7) + ((size_t)l * 4 + h) * 465;
          for (int i = threadIdx.x; i < 466; i += 512) tab[i] = i < 465 ? src[i] * L2E : -INFINITY;
          __syncthreads(); }
        P.Q = QKV + (r0 + qb * 256) * INWP + 512 + h * 64; P.K = QKV + r0 * INWP + 768 + h * 64; P.V = QKV + r0 * INWP + 1024 + h * 64; P.O = BR + (r0 + qb * 256) * 1024 + 256 + h * 64;
        P.ldq = INWP; P.ldk = INWP; P.ldv = INWP; P.ldo = 1024; P.q0 = qb * 256;
        const int ra = qb * 4, rb = qb * 4 + 3;
        int lo = ra - 4; lo = lo < 0 ? 0 : (lo > 248 ? 248 : lo);
        int hi = rb - 4; hi = hi < 0 ? 0 : (hi > 248 ? 248 : hi); hi += 8;
        if ((hi - lo) & 1) { if (hi < 256) ++hi; else --lo; }
        P.t_lo = lo; P.nt = hi - lo; P.cscale = 0.125f * L2E;
        att::attn_unit<2>(P, ldsg); }
}

template <int S_>
__device__ __forceinline__ void run_sub(const Params& kp, int l, LAS unsigned char* lds, unsigned char* lds_raw, int gw, int NGW, int lane, int vcu, int G, int bx) {
    constexpr int s = S_;
    unsigned char* ws = PWS();
    bf16* H = (bf16*)POUT();
    bf16* XR = (bf16*)(ws + WS_H);
    bf16* BR = (bf16*)(ws + WS_BR); bf16* BIG = (bf16*)(ws + WS_BIG);
    unsigned char* wb = ws + WS_W + (size_t)l * W_LAYER;
    pg8::StaticOrder S;
    if constexpr (s == 0) { if (EN(1)) { if (l == 0) phase_norm(PIN(0), PIN(1), H, gw, NGW, lane); else phase_norm_bf(XR, PIN(1) + l * DM, H, gw, NGW, lane); } }
    else if constexpr (s == 2) { if (EN(3)) phase_prep(kp, lds, l, gw, NGW, lane); }
    else if constexpr (s == 4) { if (EN(5)) { phase_attention(kp, lds, l, (char*)lds_raw, vcu, G); if (PROBE_DUP == 1 && l == 0) { __syncthreads(); phase_attention(kp, lds, l, (char*)lds_raw, vcu, G); } } }
    else if constexpr (s == 8) { if (EN(9)) phase_norm_bf(XR, PIN(15) + l * DM, H, gw, NGW, lane); }
    else if constexpr (s == 1 || s == 3 || s == 5) {
        if (EN(2)) {
        pg8::Gemm g; pg8::EpiBf16<0> E;
        if (s == 1) { g = pg8::Gemm{H, (const bf16*)(wb + WO_IN), T_TOK, INWP, DM, DM, DM, 30, 0}; E = pg8::EpiBf16<0>{BIG + BIG_QKV / 2, INWP}; }
        else if (s == 3) { g = pg8::Gemm{BIG + BIG_DA / 2, (const bf16*)(wb + WO_D), T_TOK, 1024, 384, 384, 384, 30, 0}; E = pg8::EpiBf16<0>{BIG + BIG_DX / 2, 1024}; }
        else { g = pg8::Gemm{BR, (const bf16*)(wb + WO_B), T_TOK, 4096, 256, 1024, 256, 2, 256}; E = pg8::EpiBf16<0>{BIG, 4096}; }
        S.init(T_TOK, g.N, G, bx);
        pg8::gemm_phase<pg8::EpiBf16<0>, true>(lds, g, S, E); } }
    else if constexpr (s == 6) {
        if (EN(7)) {
        pg8::Gemm g{H, (const bf16*)(wb + WO_G), T_TOK, 4096, DM, DM, DM, 30, 0}; S.init(T_TOK, 4096, G, bx);
        pg8::EpiMerge E{BIG, PIN(4) + (size_t)l * 4096, BR};
        pg8::gemm_phase<pg8::EpiMerge, true>(lds, g, S, E); } }
    else if constexpr (s == 9) {
        if (EN(10)) {
        pg8::Gemm g{H, (const bf16*)(wb + WO_1), T_TOK, FF, DM, DM, DM, 30, 0}; S.init(T_TOK, FF, G, bx);
        pg8::EpiBf16<1> E{BIG, FF};
        pg8::gemm_phase<pg8::EpiBf16<1>, true>(lds, g, S, E);
        if (PROBE_DUP == 2 && l == 0) pg8::gemm_phase<pg8::EpiBf16<1>, true>(lds, g, S, E); } }
    else {
        if (EN(8)) {
        pg8::Gemm g;
        if (s == 7) g = pg8::Gemm{BR, (const bf16*)(wb + WO_O), T_TOK, DM, DM, DM, DM, 30, 0};
        else g = pg8::Gemm{BIG, (const bf16*)(wb + WO_2), T_TOK, DM, FF, FF, FF, 30, 0};
        S.init(T_TOK, DM, G, bx);
        if (s == 7 && l == 0) { pg8::EpiRes<false> E{PIN(0), XR, DM}; pg8::gemm_phase<pg8::EpiRes<false>, true>(lds, g, S, E); }
        else { pg8::EpiRes<true> E{XR, XR, DM}; pg8::gemm_phase<pg8::EpiRes<true>, true>(lds, g, S, E); } } }
}

__global__ void __launch_bounds__(512, 2) fwd_megakernel(Params p) {
    extern __shared__ __attribute__((aligned(16))) unsigned char lds_raw[];
    cg::grid_group grid = cg::this_grid();
    LAS unsigned char* lds = (LAS unsigned char*)lds_raw;
    const int tid = threadIdx.x, lane = tid & 63, wave = __builtin_amdgcn_readfirstlane(tid >> 6);
    const int G = gridDim.x, bx = blockIdx.x;
    const int vcu = (G % 8 == 0) ? (bx % 8) * (G / 8) + bx / 8 : bx;
    const int gw = vcu * 8 + wave, NGW = G * 8;
    const int ph_lo = p.ph_lo, ph_hi = p.ph_hi;
    volatile LAS unsigned* MISC = (volatile LAS unsigned*)(lds + PAR_OFF);
    if (tid < 2) MISC[tid] = 0u;
    __syncthreads();
    const XcdBarrier xbar = xcd_barrier_post((unsigned*)p.ws, MISC);
#define RUN_PH(ph, ...) do { if (ph_lo <= (ph) && (ph) < ph_hi) { __VA_ARGS__; if ((ph) + 1 < ph_hi) { if ((ph) == 0) grid.sync(); else xcd_barrier(xbar); } } } while (0)
#define RUN_SUB(L, S_) RUN_PH(1 + (L) * 11 + (S_), run_sub<S_>(p, (L), lds, lds_raw, gw, NGW, lane, vcu, G, bx))
#define RUN_LAYER(L) do { RUN_SUB(L, 0); RUN_SUB(L, 1); RUN_SUB(L, 2); RUN_SUB(L, 3); RUN_SUB(L, 4); RUN_SUB(L, 5); RUN_SUB(L, 6); RUN_SUB(L, 7); RUN_SUB(L, 8); RUN_SUB(L, 9); RUN_SUB(L, 10); } while (0)
#define RUN_LAYER_REST(L) do { RUN_SUB(L, 1); RUN_SUB(L, 2); RUN_SUB(L, 3); RUN_SUB(L, 4); RUN_SUB(L, 5); RUN_SUB(L, 6); RUN_SUB(L, 7); RUN_SUB(L, 8); RUN_SUB(L, 9); RUN_SUB(L, 10); } while (0)
    RUN_PH(0, if (EN(0)) { phase_prologue(p, lds, gw, NGW, wave, lane); run_sub<0>(p, 0, lds, lds_raw, gw, NGW, lane, vcu, G, bx); });
    RUN_LAYER_REST(0);
    RUN_SUB(1, 0);
    RUN_LAYER_REST(1);
    RUN_PH(23, if (EN(12)) phase_final_norm((const bf16*)(p.ws + WS_H), p.in[18], p.out, gw, NGW, lane));
}

extern "C" void kernel_launch(void* const* d_in, const int* in_sizes, int n_in, void* d_out, int out_size, void* d_ws, size_t ws_size, hipStream_t stream) {
    static int grid = 0;
    if (grid == 0) {
        if (n_in != 19 || in_sizes[0] != T_TOK * DM || out_size != T_TOK * DM || ws_size < WS_END) {
            fprintf(stderr, "kernel_launch: unexpected shapes (n_in %d, in0 %d, out %d, ws %zu); nothing launched\n", n_in, n_in > 0 ? in_sizes[0] : -1, out_size, ws_size); grid = -1; return; }
        int dev = 0, cus = 0, per_cu = 0;
        if (hipGetDevice(&dev) != hipSuccess || hipDeviceGetAttribute(&cus, hipDeviceAttributeMultiprocessorCount, dev) != hipSuccess) { grid = -1; return; }
        if (hipFuncSetAttribute((const void*)fwd_megakernel, hipFuncAttributeMaxDynamicSharedMemorySize, LDS_TOTAL) != hipSuccess) { fprintf(stderr, "kernel_launch: hipFuncSetAttribute failed\n"); grid = -1; return; }
        if (hipOccupancyMaxActiveBlocksPerMultiprocessor(&per_cu, (const void*)fwd_megakernel, 512, LDS_TOTAL) != hipSuccess || per_cu < 1) { fprintf(stderr, "kernel_launch: occupancy query failed (%d)\n", per_cu); per_cu = 1; }
        (void)hipGetLastError();
        grid = cus * per_cu;
    }
    if (grid < 0) return;
    if (hipMemsetAsync(d_ws, 0, 16384, stream) != hipSuccess) { fprintf(stderr, "kernel_launch: memset of the barrier words failed\n"); return; }
    Params prm{};
    for (int i = 0; i < 19; ++i) prm.in[i] = (const float*)d_in[i];
    prm.out = (float*)d_out; prm.ws = (unsigned char*)d_ws;
#if MK_PER_PHASE
    for (int ph = 0; ph < 24; ++ph) { prm.ph_lo = ph; prm.ph_hi = ph + 1; void* args[] = {&prm};
        hipError_t e = hipLaunchCooperativeKernel((const void*)fwd_megakernel, dim3(grid), dim3(512), args, LDS_TOTAL, stream);
        if (e != hipSuccess) { fprintf(stderr, "cooperative launch failed: %s (grid %d)\n", hipGetErrorString(e), grid); break; } }
#else
    prm.ph_lo = 0; prm.ph_hi = 24; void* args[] = {&prm};
    hipError_t e = hipLaunchCooperativeKernel((const void*)fwd_megakernel, dim3(grid), dim3(512), args, LDS_TOTAL, stream);
    if (e != hipSuccess) fprintf(stderr, "cooperative launch failed: %s (grid %d)\n", hipGetErrorString(e), grid);
#endif
}
```

```cpp
#include <hip/hip_runtime.h>
#include <hip/hip_cooperative_groups.h>
#include <cstdio>
#include <cstdint>
namespace cg = cooperative_groups;

#ifndef PROBE_DUP
#define PROBE_DUP 0
#endif
#ifndef MK_PER_PHASE
#define MK_PER_PHASE 0
#endif

namespace pg8 {
#define PG8_LAS __attribute__((address_space(3)))
typedef unsigned short bf16_t;
typedef short bf16x8 __attribute__((ext_vector_type(8)));
typedef float f32x4 __attribute__((ext_vector_type(4)));
typedef float f32x2 __attribute__((ext_vector_type(2)));
typedef unsigned u32x4 __attribute__((ext_vector_type(4)));
typedef unsigned u32x2 __attribute__((ext_vector_type(2)));
constexpr int BM = 256, BK = 64, HALF = 128, HTB = HALF * BK * 2, STAGE_BYTES = 8 * HTB, NXCD = 8, WGM = 8;

__host__ __device__ __forceinline__ int lds_byte(int r, int c) { const int st = (r >> 4) * 2 + (c >> 5), rr = r & 15, cc = c & 31, ob = rr * 64 + cc * 2; return st * 1024 + (ob ^ (((ob >> 9) & 1) << 5)); }
__host__ __device__ __forceinline__ void stage_rc(int b, int& R, int& C) { const int st = b / 1024, sb = b % 1024, swz = sb ^ (((sb >> 9) & 1) << 5); R = (st >> 1) * 16 + swz / 64; C = (st & 1) * 32 + (swz % 64) / 2; }
__host__ __device__ __forceinline__ int perm32(int rho) { const int n = rho >> 4, i = rho & 15; return 8 * (i >> 2) + 4 * n + (i & 3); }

struct Unit { int pm, pn; };
struct Gemm { const bf16_t* A; const bf16_t* Bt; int M, N, K, lda, ldb, a_shift, a_zoff; };

struct StaticOrder {
    int nM, nN, nwg, G, c;
    __device__ void init(int M, int N, int G_, int c_) { nM = M / BM; nN = N / BM; nwg = nM * nN; G = G_; c = c_; }
    __device__ bool next(int i, Unit& u) const {
        const long L = (long)i * G + c; if (L >= nwg) return false;
        int wgid = (int)L; { const int q = nwg / NXCD, r = nwg % NXCD, xcd = wgid % NXCD, off = wgid / NXCD; wgid = (xcd < r ? xcd * (q + 1) : r * (q + 1) + (xcd - r) * q) + off; }
        const int nig = WGM * nN, gid = wgid / nig, fm = gid * WGM, gsz = (nM - fm) < WGM ? (nM - fm) : WGM;
        u.pm = fm + ((wgid % nig) % gsz); u.pn = (wgid % nig) / gsz; return true;
    }
};

__device__ __forceinline__ unsigned cvt_pk_bf16(float lo, float hi) { unsigned r; asm volatile("v_cvt_pk_bf16_f32 %0, %1, %2" : "=v"(r) : "v"(lo), "v"(hi)); return r; }
__device__ __forceinline__ float bf_lo(unsigned w) { return __uint_as_float(w << 16); }
__device__ __forceinline__ float bf_hi(unsigned w) { return __uint_as_float(w & 0xffff0000u); }

template <int ACT  > struct EpiBf16 {
    static constexpr bool PERM = true;
    bf16_t* O; int ldc;
    __device__ __forceinline__ void operator()(const f32x4 (&acc)[2][2][4][2], const Unit& u, int wr, int wc, int fr, int fq) const {
        const int row0 = u.pm * BM + wr * 64 + fr, col0 = u.pn * BM + wc * 32 + 8 * fq;
#pragma unroll
        for (int ai = 0; ai < 2; ++ai)
#pragma unroll
            for (int m = 0; m < 4; ++m) { bf16_t* rowp = O + (size_t)(row0 + ai * HALF + m * 16) * ldc + col0;
#pragma unroll
                for (int bj = 0; bj < 2; ++bj) { f32x4 v0 = acc[ai][bj][m][0], v1 = acc[ai][bj][m][1];
                    if (ACT == 1) {
#pragma unroll
                        for (int e = 0; e < 4; ++e) { float a = fmaxf(v0[e], 0.f), b = fmaxf(v1[e], 0.f); v0[e] = a * a; v1[e] = b * b; } }
                    u32x4 w; w.x = cvt_pk_bf16(v0[0], v0[1]); w.y = cvt_pk_bf16(v0[2], v0[3]); w.z = cvt_pk_bf16(v1[0], v1[1]); w.w = cvt_pk_bf16(v1[2], v1[3]);
                    *(u32x4*)(rowp + bj * HALF) = w; } }
    }
};
struct EpiMerge {
    static constexpr bool PERM = true;
    const bf16_t* Y; const float* bg; bf16_t* Z;
    __device__ __forceinline__ void operator()(const f32x4 (&acc)[2][2][4][2], const Unit& u, int wr, int wc, int fr, int fq) const {
        const int row0 = u.pm * BM + wr * 64 + fr, dcol = u.pn * 64 + 16 * wc + 4 * fq;
        f32x4 bv[2][2];
#pragma unroll
        for (int bj = 0; bj < 2; ++bj)
#pragma unroll
            for (int n = 0; n < 2; ++n) bv[bj][n] = *(const f32x4*)(bg + (2 * bj + n) * 1024 + dcol);
#pragma unroll
        for (int ai = 0; ai < 2; ++ai)
#pragma unroll
            for (int m = 0; m < 4; ++m) { const size_t r = (size_t)(row0 + ai * HALF + m * 16);
                const bf16_t* yp = Y + r * 4096 + dcol;
                f32x4 z = (f32x4){0.f, 0.f, 0.f, 0.f};
#pragma unroll
                for (int bj = 0; bj < 2; ++bj)
#pragma unroll
                    for (int n = 0; n < 2; ++n) { const u32x2 yw = *(const u32x2*)(yp + (2 * bj + n) * 1024);
                        const f32x4 y = (f32x4){bf_lo(yw.x), bf_hi(yw.x), bf_lo(yw.y), bf_hi(yw.y)};
                        const f32x4 a = acc[ai][bj][m][n] + bv[bj][n];
#pragma unroll
                        for (int e = 0; e < 4; ++e) z[e] += __builtin_amdgcn_rcpf(1.f + __builtin_amdgcn_exp2f(a[e] * -1.4426950408889634f)) * y[e]; }
                u32x2 w; w.x = cvt_pk_bf16(z[0], z[1]); w.y = cvt_pk_bf16(z[2], z[3]);
                *(u32x2*)(Z + r * 1024 + dcol) = w; }
    }
};
template <bool BBF> struct EpiRes {
    static constexpr bool PERM = true;
    const void* base; bf16_t* out; int ldc;
    __device__ __forceinline__ void operator()(const f32x4 (&acc)[2][2][4][2], const Unit& u, int wr, int wc, int fr, int fq) const {
        const int row0 = u.pm * BM + wr * 64 + fr, col0 = u.pn * BM + wc * 32 + 8 * fq;
#pragma unroll
        for (int ai = 0; ai < 2; ++ai)
#pragma unroll
            for (int m = 0; m < 4; ++m) { const size_t off = (size_t)(row0 + ai * HALF + m * 16) * ldc + col0;
#pragma unroll
                for (int bj = 0; bj < 2; ++bj) { f32x4 b0, b1;
                    if (BBF) { const u32x4 w = *(const u32x4*)((const bf16_t*)base + off + bj * HALF);
                        b0 = (f32x4){bf_lo(w.x), bf_hi(w.x), bf_lo(w.y), bf_hi(w.y)}; b1 = (f32x4){bf_lo(w.z), bf_hi(w.z), bf_lo(w.w), bf_hi(w.w)}; }
                    else { const float* bp = (const float*)base + off + bj * HALF; b0 = *(const f32x4*)bp; b1 = *(const f32x4*)(bp + 4); }
                    const f32x4 v0 = b0 + acc[ai][bj][m][0], v1 = b1 + acc[ai][bj][m][1];
                    u32x4 w; w.x = cvt_pk_bf16(v0[0], v0[1]); w.y = cvt_pk_bf16(v0[2], v0[3]); w.z = cvt_pk_bf16(v1[0], v1[1]); w.w = cvt_pk_bf16(v1[2], v1[3]);
                    *(u32x4*)(out + off + bj * HALF) = w; } }
    }
};

template <class Epi, bool ALIGN_EPI>
__device__ __forceinline__ void gemm_phase(PG8_LAS unsigned char* lds, const Gemm g, const StaticOrder& S, const Epi& E) {
    int tid = threadIdx.x; asm volatile("" : "+v"(tid));
    const int wid = __builtin_amdgcn_readfirstlane(tid >> 6), lane = tid & 63, wr = wid >> 2, wc = wid & 3, fr = lane & 15, fq = lane >> 4;
    const int K = g.K, nt = K / BK;
    unsigned voffA[2], voffB[2];
#pragma unroll
    for (int i = 0; i < 2; ++i) { int R, C; stage_rc(tid * 16 + i * 8192, R, C); const int Rb = Epi::PERM ? ((R & ~31) + perm32(R & 31)) : R;
        voffA[i] = (unsigned)(R * g.lda + C) * 2u; voffB[i] = (unsigned)(Rb * g.ldb + C) * 2u; }
    const size_t kstep = (size_t)(BK * 2);
    const size_t hstepA = (size_t)HALF * g.lda * 2, hstepB = (size_t)HALF * g.ldb * 2;
    const size_t tstepA = 2 * hstepA, tstepB = 2 * hstepB;
    const unsigned ldsw = (unsigned)wid * 1024u;
    const int aoff = lds_byte(wr * 64 + fr, fq * 8), boff = lds_byte(wc * 32 + fr, fq * 8);
#define PG8_SA(b, h) (((b) * 2 + (h)) * HTB)
#define PG8_SB(b, h) ((4 + (b) * 2 + (h)) * HTB)
#define PG8_STAGE(bufoff, gbase, voff) do { _Pragma("unroll") for (int _i = 0; _i < 2; ++_i) \
        __builtin_amdgcn_global_load_lds((const unsigned*)((const char*)(gbase) + (voff)[_i]), (PG8_LAS unsigned*)(lds + (bufoff) + ldsw + _i * 8192), 16, 0, 0); } while (0)
#define PG8_LDA(dst, b, h) do { _Pragma("unroll") for (int m = 0; m < 4; ++m) _Pragma("unroll") for (int k = 0; k < 2; ++k) dst[m][k] = *(const PG8_LAS bf16x8*)(lds + PG8_SA(b, h) + aoff + m * 2048 + k * 1024); } while (0)
#define PG8_LDB(dst, b, h) do { _Pragma("unroll") for (int n = 0; n < 2; ++n) _Pragma("unroll") for (int k = 0; k < 2; ++k) dst[n][k] = *(const PG8_LAS bf16x8*)(lds + PG8_SB(b, h) + boff + n * 2048 + k * 1024); } while (0)
#define PG8_MMA(ai, bj, At, Bt) do { __builtin_amdgcn_s_setprio(1); _Pragma("unroll") for (int m = 0; m < 4; ++m) _Pragma("unroll") for (int n = 0; n < 2; ++n) _Pragma("unroll") for (int k = 0; k < 2; ++k) \
        acc[ai][bj][m][n] = __builtin_amdgcn_mfma_f32_16x16x32_bf16(Bt[n][k], At[m][k], acc[ai][bj][m][n], 0, 0, 0); __builtin_amdgcn_s_setprio(0); } while (0)
#define PG8_WAIT_V(n) asm volatile("s_waitcnt vmcnt(" #n ")" ::: "memory")
#define PG8_WAIT_L(n) asm volatile("s_waitcnt lgkmcnt(" #n ")" ::: "memory")
#define PG8_BAR __builtin_amdgcn_s_barrier()
#define PG8_SCHED __builtin_amdgcn_sched_barrier(0)
#define PG8_APTR(uu) ((const char*)g.A + (size_t)(uu).pm * tstepA + (size_t)((uu).pn >> g.a_shift) * (size_t)g.a_zoff * 2)
    Unit cur, nxt; int ui = 0;
    if (!S.next(0, cur)) return;
    f32x4 acc[2][2][4][2];
#pragma unroll
    for (int a = 0; a < 2; ++a)
#pragma unroll
        for (int b = 0; b < 2; ++b)
#pragma unroll
            for (int m = 0; m < 4; ++m)
#pragma unroll
                for (int n = 0; n < 2; ++n) acc[a][b][m][n] = (f32x4){0.f, 0.f, 0.f, 0.f};
    bf16x8 At[4][2], B0[2][2], B1[2][2];
    const char* cA = PG8_APTR(cur); const char* cB = (const char*)g.Bt + (size_t)cur.pn * tstepB;
    PG8_STAGE(PG8_SB(0, 0), cB, voffB); PG8_STAGE(PG8_SB(0, 1), cB + hstepB, voffB); PG8_STAGE(PG8_SA(0, 0), cA, voffA); PG8_STAGE(PG8_SA(0, 1), cA + hstepA, voffA);
    if (wr == 1) PG8_BAR;
    PG8_WAIT_V(2); PG8_BAR;
    PG8_STAGE(PG8_SB(1, 0), cB + kstep, voffB); PG8_STAGE(PG8_SA(1, 0), cA + kstep, voffA); PG8_STAGE(PG8_SB(1, 1), cB + hstepB + kstep, voffB);
    PG8_WAIT_V(6); PG8_BAR;
    for (;;) {
        const bool has_next = S.next(ui + 1, nxt);
        const char* nA = has_next ? PG8_APTR(nxt) : cA; const char* nB = has_next ? (const char*)g.Bt + (size_t)nxt.pn * tstepB : cB;
        for (int t = 0; t < nt; t += 2) {
            const bool last = (t == nt - 2);
            const char* a1 = cA + (size_t)(t + 1) * kstep;
            const char* a2 = last ? nA : cA + (size_t)(t + 2) * kstep; const char* b2 = last ? nB : cB + (size_t)(t + 2) * kstep;
            const char* a3 = a2 + kstep; const char* b3 = b2 + kstep;
            PG8_LDB(B0, 0, 0); PG8_LDB(B1, 0, 1); PG8_SCHED; PG8_LDA(At, 0, 0); PG8_STAGE(PG8_SA(1, 1), a1 + hstepA, voffA);
            PG8_WAIT_V(8); PG8_WAIT_L(0); PG8_BAR; PG8_MMA(0, 0, At, B0); PG8_MMA(0, 1, At, B1); PG8_BAR; PG8_SCHED;
            PG8_LDA(At, 0, 1); PG8_STAGE(PG8_SB(0, 0), b2, voffB); PG8_STAGE(PG8_SB(0, 1), b2 + hstepB, voffB); PG8_STAGE(PG8_SA(0, 0), a2, voffA);
            PG8_WAIT_V(8); PG8_WAIT_L(0); PG8_BAR; PG8_MMA(1, 0, At, B0); PG8_MMA(1, 1, At, B1); PG8_BAR; PG8_SCHED;
            PG8_LDB(B0, 1, 0); PG8_LDB(B1, 1, 1); PG8_SCHED; PG8_LDA(At, 1, 0); PG8_STAGE(PG8_SA(0, 1), a2 + hstepA, voffA);
            PG8_WAIT_V(8); PG8_WAIT_L(0); PG8_BAR; PG8_MMA(0, 0, At, B0); PG8_MMA(0, 1, At, B1); PG8_BAR; PG8_SCHED;
            PG8_LDA(At, 1, 1); PG8_STAGE(PG8_SB(1, 0), b3, voffB); PG8_STAGE(PG8_SB(1, 1), b3 + hstepB, voffB); PG8_STAGE(PG8_SA(1, 0), a3, voffA);
            PG8_WAIT_V(8); PG8_WAIT_L(0); PG8_BAR; PG8_MMA(1, 0, At, B0); PG8_MMA(1, 1, At, B1); PG8_BAR; PG8_SCHED;
        }
        if constexpr (ALIGN_EPI) { if (wr == 0) PG8_BAR; }
        E(acc, cur, wr, wc, fr, fq);
        if (!has_next) break;
#pragma unroll
        for (int a = 0; a < 2; ++a)
#pragma unroll
            for (int b = 0; b < 2; ++b)
#pragma unroll
                for (int m = 0; m < 4; ++m)
#pragma unroll
                    for (int n = 0; n < 2; ++n) acc[a][b][m][n] = (f32x4){0.f, 0.f, 0.f, 0.f};
        cur = nxt; cA = nA; cB = nB; ++ui;
        if constexpr (ALIGN_EPI) { if (wr == 1) PG8_BAR; }
    }
    PG8_WAIT_V(0);
    if constexpr (!ALIGN_EPI) { if (wr == 0) PG8_BAR; }
    PG8_BAR;
#undef PG8_SA
#undef PG8_SB
#undef PG8_STAGE
#undef PG8_LDA
#undef PG8_LDB
#undef PG8_MMA
#undef PG8_WAIT_V
#undef PG8_WAIT_L
#undef PG8_BAR
#undef PG8_SCHED
#undef PG8_APTR
}
}

namespace att {
typedef unsigned short bf16_t;
typedef short bf16x8 __attribute__((ext_vector_type(8)));
typedef short s16x4 __attribute__((ext_vector_type(4)));
typedef float f32x16 __attribute__((ext_vector_type(16)));
typedef float f32x4 __attribute__((ext_vector_type(4)));
typedef unsigned u32x4 __attribute__((ext_vector_type(4)));
typedef unsigned u32x2 __attribute__((ext_vector_type(2)));
constexpr int SHM_V = 8192, SHM_K = 16384;
constexpr int OFF_V = 0, OFF_K = 2 * SHM_V, OFF_WS = OFF_K + 2 * SHM_K, OFF_TAB = OFF_WS + 2048, LDS_BYTES = OFF_TAB + 2048;
constexpr float LOG2E = 1.4426950408889634f;
constexpr float THR2 = 8.f * LOG2E;
#define SBAR() __builtin_amdgcn_sched_barrier(0)
__device__ __forceinline__ int crow(int r, int hi) { return (r & 3) + 8 * (r >> 2) + 4 * hi; }
__device__ __forceinline__ unsigned cvtpk(float lo, float hi) { unsigned r; asm volatile("v_cvt_pk_bf16_f32 %0, %1, %2" : "=v"(r) : "v"(lo), "v"(hi)); return r; }
__device__ __forceinline__ float bf_lo(unsigned w) { return __uint_as_float(w << 16); }
__device__ __forceinline__ float bf_hi(unsigned w) { return __uint_as_float(w & 0xffff0000u); }

struct UnitP {
    const bf16_t* Q; const bf16_t* K; const bf16_t* V; bf16_t* O;
    const bf16_t* K2;
    int ldq, ldk, ldv, ldo;
    int t_lo, nt;
    int q0;
    float cscale;
    float slope2, sink2;
    const float* cosT; const float* sinT;
};

template <int DQK> __device__ __forceinline__ int kaddr(int row, int chunk) {
    if (DQK == 64) return row * 128 + ((chunk ^ ((row >> 1) & 7)) << 4);
    else return row * 256 + ((chunk ^ (row & 15)) << 4);
}
__device__ __forceinline__ int v_st(int k, int c) { const int kk = (k & ~0xC) | ((k & 4) << 1) | ((k & 8) >> 1); return ((kk >> 3) * 2 + (c >> 5)) * 512 + ((kk & 7) * 32 + (c & 31)) * 2; }
__device__ __forceinline__ int v_rd_base(int lane) { return ((lane & 3) << 3) | (((lane >> 2) & 3) << 6) | (((lane >> 4) & 1) << 5) | (((lane >> 5) & 1) << 8); }
constexpr int v_rd_off(int d0, int ks, int half) { return d0 * 512 + ks * 2048 + half * 1024; }
template <int OFF> __device__ __forceinline__ s16x4 tr_read(int vb) { s16x4 r; asm volatile("ds_read_b64_tr_b16 %0, %1 offset:%2" : "=&v"(r) : "v"(vb), "i"(OFF) : "memory"); return r; }
template <int D0> __device__ __forceinline__ void pv_one(f32x16& od, int vb, bf16x8 pa0, bf16x8 pa1, bf16x8 pa2, bf16x8 pa3) {
    const s16x4 l0 = tr_read<v_rd_off(D0, 0, 0)>(vb), h0 = tr_read<v_rd_off(D0, 0, 1)>(vb), l1 = tr_read<v_rd_off(D0, 1, 0)>(vb), h1 = tr_read<v_rd_off(D0, 1, 1)>(vb);
    const s16x4 l2 = tr_read<v_rd_off(D0, 2, 0)>(vb), h2 = tr_read<v_rd_off(D0, 2, 1)>(vb), l3 = tr_read<v_rd_off(D0, 3, 0)>(vb), h3 = tr_read<v_rd_off(D0, 3, 1)>(vb);
    asm volatile("s_waitcnt lgkmcnt(0)" ::: "memory"); SBAR();
#define PK(L, H) (bf16x8){L[0], L[1], L[2], L[3], H[0], H[1], H[2], H[3]}
    od = __builtin_amdgcn_mfma_f32_32x32x16_bf16(pa0, PK(l0, h0), od, 0, 0, 0);
    od = __builtin_amdgcn_mfma_f32_32x32x16_bf16(pa1, PK(l1, h1), od, 0, 0, 0);
    od = __builtin_amdgcn_mfma_f32_32x32x16_bf16(pa2, PK(l2, h2), od, 0, 0, 0);
    od = __builtin_amdgcn_mfma_f32_32x32x16_bf16(pa3, PK(l3, h3), od, 0, 0, 0);
#undef PK
}
__device__ __forceinline__ void partialSM(f32x16& p0, f32x16& p1, float& m_reg, float& alpha) {
    float pmax = p0[0];
#pragma unroll
    for (int r = 1; r < 16; ++r) pmax = fmaxf(pmax, p0[r]);
#pragma unroll
    for (int r = 0; r < 16; ++r) pmax = fmaxf(pmax, p1[r]);
    { auto rr = __builtin_amdgcn_permlane32_swap(__float_as_uint(pmax), __float_as_uint(pmax), false, false);
      pmax = fmaxf(__uint_as_float(rr[0]), __uint_as_float(rr[1])); }
    float mn;
    if (__builtin_expect(__all(pmax - m_reg <= THR2), 1)) { mn = m_reg; alpha = 1.f; }
    else { mn = fmaxf(m_reg, pmax); alpha = __builtin_amdgcn_exp2f(m_reg - mn); m_reg = mn; }
#pragma unroll
    for (int r = 0; r < 16; ++r) p0[r] = p0[r] - mn;
#pragma unroll
    for (int r = 0; r < 16; ++r) p1[r] = p1[r] - mn;
#pragma unroll
    for (int r = 0; r < 16; ++r) p0[r] = __builtin_amdgcn_exp2f(p0[r]);
}
__device__ __forceinline__ void finishSM(f32x16& p0, f32x16& p1, float alpha, float& l_reg, bf16x8& pa0, bf16x8& pa1, bf16x8& pa2, bf16x8& pa3) {
#pragma unroll
    for (int r = 0; r < 16; ++r) p1[r] = __builtin_amdgcn_exp2f(p1[r]);
    float ps = 0;
#pragma unroll
    for (int r = 0; r < 16; ++r) ps += p0[r];
#pragma unroll
    for (int r = 0; r < 16; ++r) ps += p1[r];
    { auto rr = __builtin_amdgcn_permlane32_swap(__float_as_uint(ps), __float_as_uint(ps), false, false);
      ps = __uint_as_float(rr[0]) + __uint_as_float(rr[1]); }
    l_reg = l_reg * alpha + ps;
#define PK4(P, BASE, OUT) do { unsigned a0 = cvtpk(P[BASE + 0], P[BASE + 1]), a1 = cvtpk(P[BASE + 2], P[BASE + 3]);   \
    unsigned b0 = cvtpk(P[BASE + 4], P[BASE + 5]), b1 = cvtpk(P[BASE + 6], P[BASE + 7]);                              \
    auto r0 = __builtin_amdgcn_permlane32_swap(a0, b0, false, false); auto r1 = __builtin_amdgcn_permlane32_swap(a1, b1, false, false); \
    u32x4 w = {r0[0], r1[0], r0[1], r1[1]}; OUT = *reinterpret_cast<bf16x8*>(&w); } while (0)
    PK4(p0, 0, pa0); PK4(p0, 8, pa1); PK4(p1, 0, pa2); PK4(p1, 8, pa3);
#undef PK4
}
__device__ __forceinline__ float rowmax32(const f32x16& p0, const f32x16& p1) {
    float pmax = p0[0];
#pragma unroll
    for (int r = 1; r < 16; ++r) pmax = fmaxf(pmax, p0[r]);
#pragma unroll
    for (int r = 0; r < 16; ++r) pmax = fmaxf(pmax, p1[r]);
    auto rr = __builtin_amdgcn_permlane32_swap(__float_as_uint(pmax), __float_as_uint(pmax), false, false);
    return fmaxf(__uint_as_float(rr[0]), __uint_as_float(rr[1]));
}
template <bool FIRST> __device__ __forceinline__ void partialSM_fast(f32x16& p0, f32x16& p1, float& m_reg, f32x16& negm, float& alpha) {
    const float pmax = rowmax32(p0, p1);
    if (!FIRST && __builtin_expect(__all(pmax <= THR2), 1)) { alpha = 1.f; }
    else { const float dl = FIRST ? pmax : fmaxf(pmax, 0.f); m_reg += dl;
#pragma unroll
        for (int r = 0; r < 16; ++r) { p0[r] -= dl; p1[r] -= dl; }
#pragma unroll
        for (int r = 0; r < 16; ++r) negm[r] = -m_reg;
        alpha = __builtin_amdgcn_exp2f(-dl); }
#pragma unroll
    for (int r = 0; r < 16; ++r) p0[r] = __builtin_amdgcn_exp2f(p0[r]);
}
__device__ __forceinline__ void finishSM_fast(f32x16& p0, f32x16& p1, bf16x8& pa0, bf16x8& pa1, bf16x8& pa2, bf16x8& pa3) {
#pragma unroll
    for (int r = 0; r < 16; ++r) p1[r] = __builtin_amdgcn_exp2f(p1[r]);
#define PK4(P, BASE, OUT) do { unsigned a0 = cvtpk(P[BASE + 0], P[BASE + 1]), a1 = cvtpk(P[BASE + 2], P[BASE + 3]);   \
    unsigned b0 = cvtpk(P[BASE + 4], P[BASE + 5]), b1 = cvtpk(P[BASE + 6], P[BASE + 7]);                              \
    auto r0 = __builtin_amdgcn_permlane32_swap(a0, b0, false, false); auto r1 = __builtin_amdgcn_permlane32_swap(a1, b1, false, false); \
    u32x4 w = {r0[0], r1[0], r0[1], r1[1]}; OUT = *reinterpret_cast<bf16x8*>(&w); } while (0)
    PK4(p0, 0, pa0); PK4(p0, 8, pa1); PK4(p1, 0, pa2); PK4(p1, 8, pa3);
#undef PK4
}
__device__ __forceinline__ void pv_ones(f32x16& ol, bf16x8 pa0, bf16x8 pa1, bf16x8 pa2, bf16x8 pa3) {
    const bf16x8 ones = {0x3F80, 0x3F80, 0x3F80, 0x3F80, 0x3F80, 0x3F80, 0x3F80, 0x3F80};
    ol = __builtin_amdgcn_mfma_f32_32x32x16_bf16(pa0, ones, ol, 0, 0, 0);
    ol = __builtin_amdgcn_mfma_f32_32x32x16_bf16(pa1, ones, ol, 0, 0, 0);
    ol = __builtin_amdgcn_mfma_f32_32x32x16_bf16(pa2, ones, ol, 0, 0, 0);
    ol = __builtin_amdgcn_mfma_f32_32x32x16_bf16(pa3, ones, ol, 0, 0, 0);
}
template <int DQK> __device__ __forceinline__ void qkt_neg(f32x16& p0, f32x16& p1, const char* Ks, const bf16x8* qr, const f32x16& negm, int r32, int hi) {
#pragma unroll
    for (int d0 = 0; d0 < DQK / 16; ++d0) {
        const int a0 = kaddr<DQK>(r32, d0 * 2 + hi);
        const bf16x8 b0 = *reinterpret_cast<const bf16x8*>(Ks + a0);
        const bf16x8 b1 = *reinterpret_cast<const bf16x8*>(Ks + a0 + 32 * (DQK == 64 ? 128 : 256));
        if (d0 == 0) { p0 = __builtin_amdgcn_mfma_f32_32x32x16_bf16(b0, qr[0], negm, 0, 0, 0); p1 = __builtin_amdgcn_mfma_f32_32x32x16_bf16(b1, qr[0], negm, 0, 0, 0); }
        else { p0 = __builtin_amdgcn_mfma_f32_32x32x16_bf16(b0, qr[d0], p0, 0, 0, 0); p1 = __builtin_amdgcn_mfma_f32_32x32x16_bf16(b1, qr[d0], p1, 0, 0, 0); } }
}
template <int DQK> __device__ __forceinline__ void qkt(f32x16& p0, f32x16& p1, const char* Ks, const bf16x8* qr, int r32, int hi) {
    p0 = f32x16{}; p1 = f32x16{};
#pragma unroll
    for (int d0 = 0; d0 < DQK / 16; ++d0) {
        const int a0 = kaddr<DQK>(r32, d0 * 2 + hi);
        const bf16x8 b0 = *reinterpret_cast<const bf16x8*>(Ks + a0);
        const bf16x8 b1 = *reinterpret_cast<const bf16x8*>(Ks + a0 + 32 * (DQK == 64 ? 128 : 256));
        p0 = __builtin_amdgcn_mfma_f32_32x32x16_bf16(b0, qr[d0], p0, 0, 0, 0);
        p1 = __builtin_amdgcn_mfma_f32_32x32x16_bf16(b1, qr[d0], p1, 0, 0, 0); }
}
template <int MODE> __device__ __forceinline__ void score_fix(f32x16& p0, f32x16& p1, const UnitP& P, int tt, int wid, int r32, int hi, const float* tab) {
    const float NEG = -INFINITY;
    if (MODE == 2) {
        const int r = (P.q0 >> 6) + (wid >> 1); int c = (wid & 1) * 32 + r32; asm volatile("" : "+v"(c));
        int rs = r - 4; rs = rs < 0 ? 0 : (rs > 248 ? 248 : rs);
        int cs = c - 8; cs = cs < 0 ? 0 : (cs > 48 ? 48 : cs);
        const int kr = tt;
        if (kr < rs || kr > rs + 7) {
#pragma unroll
            for (int x = 0; x < 16; ++x) { p0[x] = NEG; p1[x] = NEG; }
        } else {
            const int ib = (kr - r + 7) * 31 + 15 - c + 4 * hi, wlo = cs - 4 * hi;
#pragma unroll
            for (int x = 0; x < 16; ++x) {
                const int kq = (x & 3) + 8 * (x >> 2);
                const int i0 = ((unsigned)(kq - wlo) < 16u) ? (ib + kq) : 465, i1 = ((unsigned)(kq + 32 - wlo) < 16u) ? (ib + kq + 32) : 465;
                p0[x] = fmaf(p0[x], P.cscale, tab[i0]); p1[x] = fmaf(p1[x], P.cscale, tab[i1]); }
        }
    } else if (MODE == 3) {
        int qpos = P.q0 + wid * 32 + r32; asm volatile("" : "+v"(qpos));
        const int kb = tt * 64, qw = P.q0 + wid * 32;
        if (kb > qw + 31 + 128 || kb + 63 < qw - 128) {
#pragma unroll
            for (int x = 0; x < 16; ++x) { p0[x] = NEG; p1[x] = NEG; }
        } else {
            const float qf = (float)(qpos - kb - 4 * hi), ns = -P.slope2;
#pragma unroll
            for (int x = 0; x < 16; ++x) {
                const float d0 = qf - (float)((x & 3) + 8 * (x >> 2)), d1 = d0 - 32.f;
                const float a0 = fabsf(d0), a1 = fabsf(d1);
                const float v0 = fmaf(a0, ns, p0[x] * P.cscale), v1 = fmaf(a1, ns, p1[x] * P.cscale);
                p0[x] = a0 <= 128.f ? v0 : NEG; p1[x] = a1 <= 128.f ? v1 : NEG; }
        }
    }
}

template <int MODE, bool NM = false>
__device__ __forceinline__ void attn_unit(const UnitP& P, char* lds) {
    constexpr int DQK = (MODE == 1) ? 96 : 64, NQ = DQK / 16, KP = (DQK == 64) ? 128 : 256;
    int tid = threadIdx.x; asm volatile("" : "+v"(tid));
    const int wid = __builtin_amdgcn_readfirstlane(tid >> 6), lane = tid & 63, r32 = lane & 31, hi = lane >> 5;
    char* V_lds = lds + OFF_V; char* K_lds = lds + OFF_K;
    float* ws = (float*)(lds + OFF_WS) + wid * 64; float* li_l = ws; float* al_l = ws + 32;
    const float* tab = (const float*)(lds + OFF_TAB);
    float m_reg = -1e30f, l_reg = 0; f32x16 o[2] = {}; bf16x8 qr[NQ];
    const bf16_t* Qw = P.Q + (size_t)(wid * 32 + r32) * P.ldq + hi * 8;
#pragma unroll
    for (int d0 = 0; d0 < NQ; ++d0) qr[d0] = *reinterpret_cast<const bf16x8*>(Qw + d0 * 16);
    if (MODE == 1) {
        const int pos = P.q0 + wid * 32 + r32;
        const f32x4 c0 = *(const f32x4*)(P.cosT + pos * 16 + hi * 8), c1 = *(const f32x4*)(P.cosT + pos * 16 + hi * 8 + 4);
        const f32x4 s0 = *(const f32x4*)(P.sinT + pos * 16 + hi * 8), s1 = *(const f32x4*)(P.sinT + pos * 16 + hi * 8 + 4);
        const float cc[8] = {c0[0], c0[1], c0[2], c0[3], c1[0], c1[1], c1[2], c1[3]}, ss[8] = {s0[0], s0[1], s0[2], s0[3], s1[0], s1[1], s1[2], s1[3]};
        const float sc = P.cscale;
#pragma unroll
        for (int d0 = 0; d0 < 4; ++d0) { u32x4 w = *reinterpret_cast<u32x4*>(&qr[d0]);
#pragma unroll
            for (int e = 0; e < 4; ++e) w[e] = cvtpk(bf_lo(w[e]) * sc, bf_hi(w[e]) * sc);
            qr[d0] = *reinterpret_cast<bf16x8*>(&w); }
        u32x4 w1 = *reinterpret_cast<u32x4*>(&qr[4]), w2 = *reinterpret_cast<u32x4*>(&qr[5]);
#pragma unroll
        for (int e = 0; e < 4; ++e) {
            const float x1a = bf_lo(w1[e]), x1b = bf_hi(w1[e]), x2a = bf_lo(w2[e]), x2b = bf_hi(w2[e]);
            const float ca = cc[2 * e], cb = cc[2 * e + 1], sa = ss[2 * e], sb = ss[2 * e + 1];
            w1[e] = cvtpk((x1a * ca - x2a * sa) * sc, (x1b * cb - x2b * sb) * sc);
            w2[e] = cvtpk((x2a * ca + x1a * sa) * sc, (x2b * cb + x1b * sb) * sc); }
        qr[4] = *reinterpret_cast<bf16x8*>(&w1); qr[5] = *reinterpret_cast<bf16x8*>(&w2);
    }
    const int srow = tid >> 3, sch = tid & 7;
    const int kst0 = kaddr<DQK>(srow, sch), kst1 = kaddr<DQK>(srow, 8 + (sch >> 1)) + (sch & 1) * 8, vst = v_st(srow, sch * 8);
    const int vb0 = (int)(uintptr_t)V_lds + v_rd_base(lane);
    const bf16_t* Kg = P.K + (size_t)srow * P.ldk + sch * 8;
    const bf16_t* Kg2 = P.K2 + (size_t)srow * 32 + sch * 4;
    const bf16_t* Vg = P.V + (size_t)srow * P.ldv + sch * 8;
    struct { u32x4 k0; u32x2 k1; u32x4 v; } sr_[2];
#define SLOAD(i, tile) do { const size_t _k = (size_t)(tile) * 64; sr_[i].k0 = *(const u32x4*)(Kg + _k * P.ldk); if (DQK == 96) sr_[i].k1 = *(const u32x2*)(Kg2 + _k * 32); \
    sr_[i].v = *(const u32x4*)(Vg + _k * P.ldv); } while (0)
#define SWRITE(b, i) do { *(u32x4*)(K_lds + (b) * SHM_K + kst0) = sr_[i].k0; if (DQK == 96) *(u32x2*)(K_lds + (b) * SHM_K + kst1) = sr_[i].k1; \
    *(u32x4*)(V_lds + (b) * SHM_V + vst) = sr_[i].v; } while (0)
#define SWAIT() do { if (DQK == 96) asm volatile("s_waitcnt vmcnt(3)" ::: "memory"); else asm volatile("s_waitcnt vmcnt(2)" ::: "memory"); } while (0)
#define RESC(a) do { if (__any((a) < 1.f)) { if (hi == 0) al_l[r32] = (a); asm volatile("s_waitcnt lgkmcnt(0)" ::: "memory"); \
    _Pragma("unroll") for (int d = 0; d < 2; ++d) _Pragma("unroll") for (int r = 0; r < 16; ++r) o[d][r] *= al_l[crow(r, hi)]; } } while (0)
#define FIX(p0, p1, tt) do { if (MODE >= 2) score_fix<MODE>(p0, p1, P, (tt), wid, r32, hi, tab); } while (0)
    f32x16 pA0, pA1, pB0, pB1; float alA, alB; bf16x8 pa0, pa1, pa2, pa3; const int NT = P.nt, T0 = P.t_lo;
    constexpr int SE = 0, SO = 1;
    constexpr bool FAST = (MODE < 2);
    f32x16 negm = {}; f32x16 ol = {};
    if (FAST) { m_reg = 0.f; asm volatile("" : "+v"(negm)); }
#define QKT(p0, p1, kb, tt) do { if (FAST) qkt_neg<DQK>(p0, p1, (kb), qr, negm, r32, hi); else { qkt<DQK>(p0, p1, (kb), qr, r32, hi); FIX(p0, p1, (tt)); } } while (0)
#define PSM(p0, p1, al) do { if (NM) { _Pragma("unroll") for (int r_ = 0; r_ < 16; ++r_) p0[r_] = __builtin_amdgcn_exp2f(p0[r_]); } else if (FAST) partialSM_fast<false>(p0, p1, m_reg, negm, al); else partialSM(p0, p1, m_reg, al); } while (0)
#define FSM(p0, p1, al) do { if (FAST) finishSM_fast(p0, p1, pa0, pa1, pa2, pa3); else finishSM(p0, p1, al, l_reg, pa0, pa1, pa2, pa3); } while (0)
#define PVT(vb) do { pv_one<0>(o[0], (vb), pa0, pa1, pa2, pa3); pv_one<1>(o[1], (vb), pa0, pa1, pa2, pa3); if (FAST) pv_ones(ol, pa0, pa1, pa2, pa3); } while (0)
#define RESC2(a) do { if (!NM && __any((a) < 1.f)) { if (hi == 0) al_l[r32] = (a); asm volatile("s_waitcnt lgkmcnt(0)" ::: "memory"); \
    _Pragma("unroll") for (int r = 0; r < 16; ++r) { const float f_ = al_l[crow(r, hi)]; o[0][r] *= f_; o[1][r] *= f_; if (FAST) ol[r] *= f_; } } } while (0)
#define SKIPT(tt) ((MODE == 2) ? (((tt) < sk_lo_) || ((tt) > sk_hi_)) : (MODE == 3) ? (((tt) < sk_lo_) || ((tt) > sk_hi_)) : false)
    int sk_lo_ = 0, sk_hi_ = 0x7fffffff;
    if (MODE == 2) { const int r_ = (P.q0 >> 6) + (wid >> 1); int rs_ = r_ - 4; rs_ = rs_ < 0 ? 0 : (rs_ > 248 ? 248 : rs_); sk_lo_ = rs_; sk_hi_ = rs_ + 7; }
    if (MODE == 3) { const int qw_ = P.q0 + wid * 32;
        int lo_ = qw_ - 128 - 63; lo_ = lo_ < 0 ? 0 : lo_; sk_lo_ = (lo_ + 63) >> 6; sk_hi_ = (qw_ + 159) >> 6; }
    bool skA = false, skB = false;
    SLOAD(SE, T0); asm volatile("s_waitcnt vmcnt(0)" ::: "memory"); SWRITE(0, SE); __syncthreads();
    skA = SKIPT(T0);
    if (skA) { alA = 1.f; }
    else if (NM) { qkt_neg<DQK>(pA0, pA1, K_lds, qr, negm, r32, hi); PSM(pA0, pA1, alA); }
    else if (FAST) { qkt_neg<DQK>(pA0, pA1, K_lds, qr, negm, r32, hi); partialSM_fast<true>(pA0, pA1, m_reg, negm, alA); }
    else { qkt<DQK>(pA0, pA1, K_lds, qr, r32, hi); FIX(pA0, pA1, T0); partialSM(pA0, pA1, m_reg, alA); }
    SLOAD(SO, T0 + 1); if (2 < NT) SLOAD(SE, T0 + 2);
    SWAIT(); SWRITE(1, SO); __syncthreads();
    for (int j = 1; j + 1 < NT; j += 2) {
        skB = SKIPT(T0 + j);
        SBAR(); if (!skB) QKT(pB0, pB1, K_lds + SHM_K, T0 + j);
        if (!skA) FSM(pA0, pA1, alA); SBAR();
        SLOAD(SO, T0 + j + 2); SBAR();
        if (!skA) PVT(vb0); if (!skB) PSM(pB0, pB1, alB); else alB = 1.f;
        __syncthreads(); SWAIT(); SWRITE(0, SE);
        RESC2(alB); __syncthreads();
        skA = SKIPT(T0 + j + 1);
        SBAR(); if (!skA) QKT(pA0, pA1, K_lds, T0 + j + 1);
        if (!skB) FSM(pB0, pB1, alB); SBAR();
        if (j + 3 < NT) SLOAD(SE, T0 + j + 3); SBAR();
        if (!skB) PVT(vb0 + SHM_V); if (!skA) PSM(pA0, pA1, alA); else alA = 1.f;
        __syncthreads(); SWAIT(); SWRITE(1, SO);
        RESC2(alA); __syncthreads();
    }
    skB = SKIPT(T0 + NT - 1);
    SBAR(); if (!skB) QKT(pB0, pB1, K_lds + SHM_K, T0 + NT - 1);
    if (!skA) FSM(pA0, pA1, alA); SBAR();
    if (!skA) PVT(vb0); if (!skB) PSM(pB0, pB1, alB); else alB = 1.f;
    __syncthreads(); RESC2(alB);
    if (!skB) { FSM(pB0, pB1, alB); SBAR();
        PVT(vb0 + SHM_V); }
#undef SKIPT
    float rli[16];
    if (FAST) {
#pragma unroll
        for (int r = 0; r < 16; ++r) rli[r] = __builtin_amdgcn_rcpf(ol[r]);
    } else {
        if (MODE == 3) l_reg += __builtin_amdgcn_exp2f(P.sink2 - m_reg);
        if (hi == 0) li_l[r32] = l_reg; asm volatile("s_waitcnt lgkmcnt(0)" ::: "memory");
#pragma unroll
        for (int r = 0; r < 16; ++r) rli[r] = __builtin_amdgcn_rcpf(li_l[crow(r, hi)]);
    }
    bf16_t* Ow = P.O + (size_t)(wid * 32) * P.ldo;
#pragma unroll
    for (int r = 0; r < 16; ++r) { const int orow = crow(r, hi);
#pragma unroll
        for (int d0 = 0; d0 < 2; ++d0) { const unsigned w = cvtpk(o[d0][r] * rli[r], 0.f); Ow[(size_t)orow * P.ldo + d0 * 32 + r32] = (bf16_t)(w & 0xffffu); } }
#undef QKT
#undef PSM
#undef FSM
#undef PVT
#undef RESC2
    __syncthreads();
#undef SLOAD
#undef SWRITE
#undef SWAIT
#undef RESC
#undef FIX
}
#undef SBAR
}

typedef unsigned short bf16;
typedef float f32x4 __attribute__((ext_vector_type(4)));
typedef unsigned u32x4 __attribute__((ext_vector_type(4)));
typedef unsigned u32x2 __attribute__((ext_vector_type(2)));
#define LAS __attribute__((address_space(3)))

constexpr int T_TOK = 32768, SEQ = 16384, DM = 1024, FF = 4096, INW = 2144, INWP = 2304, DEPTH = 2;
constexpr float EPS = 1e-6f;
constexpr size_t MiB = 1u << 20;
constexpr size_t WS_COS = 1 * MiB, WS_SIN = 2 * MiB, WS_W = 4 * MiB, W_LAYER = 34 * MiB;
constexpr size_t WO_IN = 0, WO_G = WO_IN + (size_t)INWP * 1024 * 2, WO_D = WO_G + (size_t)4096 * 1024 * 2, WO_B = WO_D + (size_t)1024 * 384 * 2,
                 WO_O = WO_B + (size_t)4096 * 256 * 2, WO_1 = WO_O + (size_t)1024 * 1024 * 2, WO_2 = WO_1 + (size_t)4096 * 1024 * 2, WO_END = WO_2 + (size_t)4096 * 1024 * 2;
static_assert(WO_END <= W_LAYER, "weight map");
constexpr size_t WS_H = 72 * MiB, WS_BR = 136 * MiB, WS_BIG = 200 * MiB, WS_END = 456 * MiB;
constexpr size_t BIG_QKV = 0, BIG_DA = 144 * MiB, BIG_DX = 168 * MiB, BIG_KR = 232 * MiB;
constexpr int LDS_TOTAL = 147456;

#ifndef EN_MASK
#define EN_MASK 0xffff
#endif
#define EN(k) ((EN_MASK >> (k)) & 1)
#ifndef ATT_MASK
#define ATT_MASK 0xf
#endif
#define AEN(k) ((ATT_MASK >> (k)) & 1)
struct Params { const float* in[19]; float* out; unsigned char* ws; int ph_lo, ph_hi; };
constexpr int PAR_OFF = 139264;
__device__ __forceinline__ unsigned long long par_get(LAS unsigned char* lds, int i) {
    volatile LAS unsigned* pp = (volatile LAS unsigned*)(lds + PAR_OFF) + 2 * i;
    const unsigned lo = __builtin_amdgcn_readfirstlane(pp[0]), hi = __builtin_amdgcn_readfirstlane(pp[1]);
    return ((unsigned long long)hi << 32) | lo;
}
#define PIN(i) (kp.in[(i)])
#define PWS() (kp.ws)
#define POUT() (kp.out)

__device__ __forceinline__ unsigned f2bf(float f) { unsigned u = __builtin_bit_cast(unsigned, f); return (u + 0x7fffu + ((u >> 16) & 1u)) >> 16; }
__device__ __forceinline__ unsigned pk2(float lo, float hi) { return f2bf(lo) | (f2bf(hi) << 16); }
__device__ __forceinline__ float bflo(unsigned w) { return __uint_as_float(w << 16); }
__device__ __forceinline__ float bfhi(unsigned w) { return __uint_as_float(w & 0xffff0000u); }
__device__ __forceinline__ float wave_sum(float v) {
#pragma unroll
    for (int o = 1; o < 64; o <<= 1) v += __shfl_xor(v, o);
    return v;
}


#define XB_TMO      128
#define XB_XCNT(j)  (256  + 64 * (j))
#define XB_XSUB(j)  (1280 + 64 * (j))
#define XB_XGEN(j)  (2304 + 64 * (j))
#define XB_TOP      3328
#define XB_TOPGEN   3392
#define XCD_BAR_WORDS 3456
#define XB_SPIN_CAP (1u << 18)
__device__ __forceinline__ unsigned xb_ld(unsigned* p)              { return __hip_atomic_load(p, __ATOMIC_RELAXED, __HIP_MEMORY_SCOPE_AGENT); }
__device__ __forceinline__ unsigned xb_add(unsigned* p, unsigned v) { return __hip_atomic_fetch_add(p, v, __ATOMIC_RELAXED, __HIP_MEMORY_SCOPE_AGENT); }
__device__ __forceinline__ unsigned xb_xcc_id() { return (unsigned)__builtin_amdgcn_s_getreg((3 << 11) | 20) & 0xFu; }
#define XB_SPIN(cond, bar) do { unsigned _sp = 0; while (cond) { __builtin_amdgcn_s_sleep(1); \
    if ((++_sp & 255u) == 0u) { if (xb_ld(&(bar)[XB_TMO])) break; if (_sp > XB_SPIN_CAP) { atomicAdd(&(bar)[XB_TMO], 1u); break; } } } } while (0)
struct XcdBarrier { unsigned* bar; unsigned x; volatile LAS unsigned* st; };
__device__ __forceinline__ XcdBarrier xcd_barrier_post(unsigned* bar, volatile LAS unsigned* st) {
    XcdBarrier b; b.bar = bar; b.x = xb_xcc_id(); b.st = st;
    if (threadIdx.x == 0) (void)xb_add(&bar[XB_XCNT(b.x)], 1u);
    return b;
}
__device__ __forceinline__ void xcd_barrier_complete(unsigned* bar, unsigned x, unsigned& nloc, unsigned& nx) {
    const unsigned G = gridDim.x * gridDim.y * gridDim.z;
    unsigned sum, cnt, mine, sp = 0u;
    for (;;) {
        sum = 0u; cnt = 0u; mine = 0u;
#pragma unroll
        for (unsigned j = 0; j < 16; ++j) { const unsigned c = xb_ld(&bar[XB_XCNT(j)]); sum += c; cnt += (c > 0u) ? 1u : 0u; mine = (j == x) ? c : mine; }
        if (sum == G) break;
        __builtin_amdgcn_s_sleep(1);
        if ((++sp & 255u) == 0u) { if (xb_ld(&bar[XB_TMO])) break; if (sp > XB_SPIN_CAP) { atomicAdd(&bar[XB_TMO], 1u); break; } }
    }
    nloc = mine > 0u ? mine : 1u; nx = cnt > 0u ? cnt : 1u;
}
__device__ __forceinline__ void xcd_barrier(const XcdBarrier& b) {
    asm volatile("s_waitcnt vmcnt(0)" ::: "memory");
    __syncthreads();
    if (threadIdx.x == 0) {
        unsigned* bar = b.bar;
        __builtin_amdgcn_s_waitcnt(0);
        unsigned nloc = b.st[0], nx = b.st[1];
        if (nloc == 0u) { xcd_barrier_complete(bar, b.x, nloc, nx); b.st[0] = nloc; b.st[1] = nx; }
        const unsigned old = xb_add(&bar[XB_XSUB(b.x)], 1u);
        const unsigned gen = old / nloc;
        if (old + 1u == (gen + 1u) * nloc) {
            __builtin_amdgcn_fence(__ATOMIC_RELEASE, "agent");
            asm volatile("s_waitcnt vmcnt(0)" ::: "memory");
            const unsigned og = xb_add(&bar[XB_TOP], 1u);
            const unsigned tg = og / nx;
            if (og + 1u == (tg + 1u) * nx) xb_add(&bar[XB_TOPGEN], 1u);
            else XB_SPIN(xb_ld(&bar[XB_TOPGEN]) == tg, bar);
            __builtin_amdgcn_fence(__ATOMIC_ACQUIRE, "agent");
            xb_add(&bar[XB_XGEN(b.x)], 1u);
            asm volatile("s_waitcnt vmcnt(0)" ::: "memory");
        } else {
            XB_SPIN(xb_ld(&bar[XB_XGEN(b.x)]) == gen, bar);
            __builtin_amdgcn_fence(__ATOMIC_ACQUIRE, "agent");
            asm volatile("s_waitcnt vmcnt(0)" ::: "memory");
        }
    }
    __syncthreads();
}

template <bool GATE>
__device__ __forceinline__ void tr_item(const float* src, int ldsrc, int k0s, int n0s, bf16* dst, int lddst, int k0d, int n0d, LAS float* scr, int lane) {
#pragma unroll 8
    for (int i = 0; i < 32; ++i) { const int kk = 2 * i + (lane >> 5); scr[kk * 33 + (lane & 31)] = src ? src[(size_t)(k0s + kk) * ldsrc + n0s + (lane & 31)] : 0.f; }
    asm volatile("s_waitcnt lgkmcnt(0)" ::: "memory");
    const int c = lane & 7;
#pragma unroll
    for (int j = 0; j < 4; ++j) { const int n = (lane >> 3) + 8 * j; const LAS float* s = scr + (8 * c) * 33 + n;
        u32x4 o; o.x = pk2(s[0 * 33], s[1 * 33]); o.y = pk2(s[2 * 33], s[3 * 33]); o.z = pk2(s[4 * 33], s[5 * 33]); o.w = pk2(s[6 * 33], s[7 * 33]);
        int drow = n0d + n;
        if (GATE) { const int nb = drow >> 10, d = drow & 1023, dl = d & 63; drow = (d >> 6) * 256 + 128 * (nb >> 1) + 32 * (dl >> 4) + 8 * ((dl >> 2) & 3) + 4 * (nb & 1) + (dl & 3); }
        *(u32x4*)(dst + (size_t)drow * lddst + k0d + 8 * c) = o; }
    asm volatile("s_waitcnt lgkmcnt(0)" ::: "memory");
}

__device__ __forceinline__ void phase_prologue(const Params& kp, LAS unsigned char* lds, int gw, int NGW, int wave, int lane) {
    asm volatile("" : "+v"(lane)); asm volatile("" : "+s"(gw));
    asm volatile("" : "+s"(wave));
    unsigned char* const ws_ = PWS();
    LAS float* scr = (LAS float*)(lds + wave * 16384);
    constexpr int I_IN = 16 * 67, I_INZ = 16 * 5, I_G = 16 * 128, I_D = 6 * 32, I_B = 4 * 4 * 32, I_O = 16 * 32, I_1 = 16 * 128, I_2 = 64 * 32;
    constexpr int PER = I_IN + I_INZ + I_G + I_D + I_B + I_O + I_1 + I_2;
    for (int it = gw; it < DEPTH * PER; it += NGW) {
        const int l = it / PER; int r = it % PER;
        unsigned char* wb = ws_ + WS_W + (size_t)l * W_LAYER;
        if (r < I_IN) { const int kb = r / 67, nb = r % 67; tr_item<false>(PIN(2) + (size_t)l * 1024 * INW, INW, kb * 64, nb * 32, (bf16*)(wb + WO_IN), 1024, kb * 64, nb * 32, scr, lane); continue; } r -= I_IN;
        if (r < I_INZ) { const int kb = r / 5, nb = r % 5; tr_item<false>(nullptr, 0, 0, 0, (bf16*)(wb + WO_IN), 1024, kb * 64, INW + nb * 32, scr, lane); continue; } r -= I_INZ;
        if (r < I_G) { const int kb = r / 128, nb = r % 128; tr_item<true>(PIN(3) + (size_t)l * 1024 * 4096, 4096, kb * 64, nb * 32, (bf16*)(wb + WO_G), 1024, kb * 64, nb * 32, scr, lane); continue; } r -= I_G;
        if (r < I_D) { const int kb = r / 32, nb = r % 32; const float* src = nullptr; int ld = 0, k0 = 0, n0 = 0;
            if (nb < 12 && kb < 3) { src = PIN(11) + (size_t)l * 192 * 384; ld = 384; k0 = kb * 64; n0 = nb * 32; }
            else if (nb >= 12 && nb < 28 && (kb == 3 || kb == 4)) { src = PIN(12) + (size_t)l * 128 * 512; ld = 512; k0 = (kb - 3) * 64; n0 = (nb - 12) * 32; }
            tr_item<false>(src, ld, k0, n0, (bf16*)(wb + WO_D), 384, kb * 64, nb * 32, scr, lane); continue; } r -= I_D;
        if (r < I_B) { const int n = r / 128, q = r % 128, kb = q / 32, nb = q % 32;
            tr_item<false>(PIN(13) + ((size_t)l * 4 + n) * 256 * 1024, 1024, kb * 64, nb * 32, (bf16*)(wb + WO_B), 256, kb * 64, n * 1024 + nb * 32, scr, lane); continue; } r -= I_B;
        if (r < I_O) { const int kb = r / 32, nb = r % 32; tr_item<false>(PIN(14) + (size_t)l * 1024 * 1024, 1024, kb * 64, nb * 32, (bf16*)(wb + WO_O), 1024, kb * 64, nb * 32, scr, lane); continue; } r -= I_O;
        if (r < I_1) { const int kb = r / 128, nb = r % 128; tr_item<false>(PIN(16) + (size_t)l * 1024 * 4096, 4096, kb * 64, nb * 32, (bf16*)(wb + WO_1), 1024, kb * 64, nb * 32, scr, lane); continue; } r -= I_1;
        { const int kb = r / 32, nb = r % 32; tr_item<false>(PIN(17) + (size_t)l * 4096 * 1024, 1024, kb * 64, nb * 32, (bf16*)(wb + WO_2), 4096, kb * 64, nb * 32, scr, lane); }
    }
    const float inv[16] = {1.000000000e+00f, 5.623413324e-01f, 3.162277639e-01f, 1.778279394e-01f, 1.000000015e-01f, 5.623413250e-02f, 3.162277490e-02f, 1.778279431e-02f,
                           9.999999776e-03f, 5.623413250e-03f, 3.162277630e-03f, 1.778279431e-03f, 1.000000047e-03f, 5.623413017e-04f, 3.162277571e-04f, 1.778279402e-04f};
    float* cosT = (float*)(ws_ + WS_COS); float* sinT = (float*)(ws_ + WS_SIN);
    for (int idx = gw * 64 + lane; idx < SEQ * 16; idx += NGW * 64) {
        const int pos = idx >> 4, i = idx & 15;
        float iv = inv[0];
#pragma unroll
        for (int q = 1; q < 16; ++q) iv = (i == q) ? inv[q] : iv;
        const float angf = (float)pos * iv;
        const double a = (double)angf;
        const double kq = __builtin_rint(a * 0.15915494309189535);
        double rr = __builtin_fma(-kq, 6.283185307179586, a); rr = __builtin_fma(-kq, 2.4492935982947064e-16, rr);
        const double r2 = rr * rr;
        double sp = -1.0 / 1.0888869450418352e28, cp = 1.0 / 4.0329146112660565e26;
        const double fs[13] = {1.0 / 1.5511210043330986e25, -1.0 / 2.5852016738884978e22, 1.0 / 5.109094217170944e19, -1.0 / 1.21645100408832e17, 1.0 / 3.55687428096e14,
                               -1.0 / 1.307674368e12, 1.0 / 6.2270208e9, -1.0 / 3.99168e7, 1.0 / 3.6288e5, -1.0 / 5.04e3, 1.0 / 1.2e2, -1.0 / 6.0, 1.0};
        const double fc[13] = {-1.0 / 6.204484017332394e23, 1.0 / 1.1240007277776077e21, -1.0 / 2.43290200817664e18, 1.0 / 6.402373705728e15, -1.0 / 2.0922789888e13,
                               1.0 / 8.71782912e10, -1.0 / 4.790016e8, 1.0 / 3.6288e6, -1.0 / 4.032e4, 1.0 / 7.2e2, -1.0 / 2.4e1, 1.0 / 2.0, -1.0};
#pragma unroll
        for (int q = 0; q < 13; ++q) { sp = __builtin_fma(sp, r2, fs[q]); cp = __builtin_fma(cp, r2, fc[q]); }
        cosT[idx] = (float)(-cp); sinT[idx] = (float)(sp * rr);
    }
}

__device__ __forceinline__ void phase_norm(const float* __restrict__ x, const float* __restrict__ g, bf16* __restrict__ out, int gw, int NGW, int lane) {
    asm volatile("" : "+v"(lane)); asm volatile("" : "+s"(gw));
    f32x4 gv[4];
#pragma unroll
    for (int j = 0; j < 4; ++j) gv[j] = ((const f32x4*)g)[lane + 64 * j];
    for (int m = gw; m < T_TOK; m += 2 * NGW) {
        const int m2 = m + NGW;
        const f32x4* xr = (const f32x4*)(x + (size_t)m * DM) + lane;
        const f32x4* xr2 = (const f32x4*)(x + (size_t)(m2 < T_TOK ? m2 : m) * DM) + lane;
        f32x4 v[4], w[4]; float s = 0.f, s2 = 0.f;
#pragma unroll
        for (int j = 0; j < 4; ++j) { v[j] = xr[64 * j]; w[j] = xr2[64 * j]; }
#pragma unroll
        for (int j = 0; j < 4; ++j) { s += (v[j].x * v[j].x + v[j].y * v[j].y) + (v[j].z * v[j].z + v[j].w * v[j].w); s2 += (w[j].x * w[j].x + w[j].y * w[j].y) + (w[j].z * w[j].z + w[j].w * w[j].w); }
        const float rstd = 1.0f / sqrtf(wave_sum(s) * (1.f / DM) + EPS), rstd2 = 1.0f / sqrtf(wave_sum(s2) * (1.f / DM) + EPS);
        u32x2* o8 = (u32x2*)(out + (size_t)m * DM) + lane;
#pragma unroll
        for (int j = 0; j < 4; ++j) { u32x2 q; q.x = pk2(v[j].x * rstd * gv[j].x, v[j].y * rstd * gv[j].y); q.y = pk2(v[j].z * rstd * gv[j].z, v[j].w * rstd * gv[j].w); o8[64 * j] = q; }
        if (m2 < T_TOK) { u32x2* o82 = (u32x2*)(out + (size_t)m2 * DM) + lane;
#pragma unroll
            for (int j = 0; j < 4; ++j) { u32x2 q; q.x = pk2(w[j].x * rstd2 * gv[j].x, w[j].y * rstd2 * gv[j].y); q.y = pk2(w[j].z * rstd2 * gv[j].z, w[j].w * rstd2 * gv[j].w); o82[64 * j] = q; } }
    }
}
__device__ __forceinline__ void phase_norm_bf(const bf16* __restrict__ x, const float* __restrict__ g, bf16* __restrict__ out, int gw, int NGW, int lane) {
    asm volatile("" : "+v"(lane)); asm volatile("" : "+s"(gw));
    f32x4 gv[2][2];
#pragma unroll
    for (int j = 0; j < 2; ++j) { gv[j][0] = *(const f32x4*)(g + 8 * lane + 512 * j); gv[j][1] = *(const f32x4*)(g + 8 * lane + 512 * j + 4); }
    for (int m = gw; m < T_TOK; m += 2 * NGW) {
        const int m2 = (m + NGW) < T_TOK ? (m + NGW) : m;
        u32x4 a[2], b[2];
#pragma unroll
        for (int j = 0; j < 2; ++j) { a[j] = *(const u32x4*)(x + (size_t)m * DM + 8 * lane + 512 * j); b[j] = *(const u32x4*)(x + (size_t)m2 * DM + 8 * lane + 512 * j); }
        float s1 = 0.f, s2 = 0.f;
#pragma unroll
        for (int j = 0; j < 2; ++j)
#pragma unroll
            for (int e = 0; e < 4; ++e) { const float p = bflo(a[j][e]), q = bfhi(a[j][e]), r = bflo(b[j][e]), t = bfhi(b[j][e]); s1 += p * p + q * q; s2 += r * r + t * t; }
        const float rs1 = 1.0f / sqrtf(wave_sum(s1) * (1.f / DM) + EPS), rs2 = 1.0f / sqrtf(wave_sum(s2) * (1.f / DM) + EPS);
#pragma unroll
        for (int j = 0; j < 2; ++j) { u32x4 w1, w2;
#pragma unroll
            for (int e = 0; e < 4; ++e) { const float g0 = gv[j][e >> 1][(e & 1) * 2], g1 = gv[j][e >> 1][(e & 1) * 2 + 1];
                w1[e] = pk2(bflo(a[j][e]) * rs1 * g0, bfhi(a[j][e]) * rs1 * g1); w2[e] = pk2(bflo(b[j][e]) * rs2 * g0, bfhi(b[j][e]) * rs2 * g1); }
            *(u32x4*)(out + (size_t)m * DM + 8 * lane + 512 * j) = w1;
            if (m2 != m) *(u32x4*)(out + (size_t)m2 * DM + 8 * lane + 512 * j) = w2; }
    }
}
__device__ __forceinline__ void phase_final_norm(const bf16* __restrict__ x, const float* __restrict__ g, float* __restrict__ out, int gw, int NGW, int lane) {
    asm volatile("" : "+v"(lane)); asm volatile("" : "+s"(gw));
    f32x4 gv[2][2];
#pragma unroll
    for (int j = 0; j < 2; ++j) { gv[j][0] = *(const f32x4*)(g + 8 * lane + 512 * j); gv[j][1] = *(const f32x4*)(g + 8 * lane + 512 * j + 4); }
    for (int m = gw; m < T_TOK; m += 2 * NGW) {
        const int m2 = (m + NGW) < T_TOK ? (m + NGW) : m;
        u32x4 a[2], b[2];
#pragma unroll
        for (int j = 0; j < 2; ++j) { a[j] = *(const u32x4*)(x + (size_t)m * DM + 8 * lane + 512 * j); b[j] = *(const u32x4*)(x + (size_t)m2 * DM + 8 * lane + 512 * j); }
        float s1 = 0.f, s2 = 0.f;
#pragma unroll
        for (int j = 0; j < 2; ++j)
#pragma unroll
            for (int e = 0; e < 4; ++e) { const float p = bflo(a[j][e]), q = bfhi(a[j][e]), r = bflo(b[j][e]), t = bfhi(b[j][e]); s1 += p * p + q * q; s2 += r * r + t * t; }
        const float rs1 = 1.0f / sqrtf(wave_sum(s1) * (1.f / DM) + EPS), rs2 = 1.0f / sqrtf(wave_sum(s2) * (1.f / DM) + EPS);
#pragma unroll
        for (int j = 0; j < 2; ++j) {
            float* o1 = out + (size_t)m * DM + 8 * lane + 512 * j; float* o2 = out + (size_t)m2 * DM + 8 * lane + 512 * j;
            const f32x4 x0 = (f32x4){bflo(a[j][0]), bfhi(a[j][0]), bflo(a[j][1]), bfhi(a[j][1])}, x1 = (f32x4){bflo(a[j][2]), bfhi(a[j][2]), bflo(a[j][3]), bfhi(a[j][3])};
            const f32x4 y0 = (f32x4){bflo(b[j][0]), bfhi(b[j][0]), bflo(b[j][1]), bfhi(b[j][1])}, y1 = (f32x4){bflo(b[j][2]), bfhi(b[j][2]), bflo(b[j][3]), bfhi(b[j][3])};
            *(f32x4*)o1 = x0 * rs1 * gv[j][0]; *(f32x4*)(o1 + 4) = x1 * rs1 * gv[j][1];
            if (m2 != m) { *(f32x4*)o2 = y0 * rs2 * gv[j][0]; *(f32x4*)(o2 + 4) = y1 * rs2 * gv[j][1]; } }
    }
}

__device__ __forceinline__ void phase_prep(const Params& kp, LAS unsigned char* lds, int l, int gw, int NGW, int lane) {
    asm volatile("" : "+v"(lane)); asm volatile("" : "+s"(gw));
    unsigned char* const ws_ = PWS();
    bf16* QKV = (bf16*)(ws_ + WS_BIG + BIG_QKV); bf16* DA = (bf16*)(ws_ + WS_BIG + BIG_DA); bf16* KR = (bf16*)(ws_ + WS_BIG + BIG_KR);
    const float* cosT = (const float*)(ws_ + WS_COS); const float* sinT = (const float*)(ws_ + WS_SIN);
    const float* gq = PIN(5) + l * 64; const float* gk = PIN(6) + l * 64; const float* gdq = PIN(9) + l * 192; const float* gdkv = PIN(10) + l * 128;
    const int m16 = lane & 15;
    const f32x4 gq4 = *(const f32x4*)(gq + m16 * 4), gk4 = *(const f32x4*)(gk + m16 * 4);
    const f32x4 gdq4 = lane < 48 ? *(const f32x4*)(gdq + lane * 4) : (f32x4){0.f, 0.f, 0.f, 0.f};
    const f32x4 gdkv4 = lane < 32 ? *(const f32x4*)(gdkv + lane * 4) : (f32x4){0.f, 0.f, 0.f, 0.f};
    const float CA = 0.125f * 1.4426950408889634f;
    struct PTok { u32x2 wq, wk, wcq, wckv, wkr; f32x4 cA, sA, cD, sD; };
    const int blk = m16 >> 3, i0 = (m16 & 7) * 4, ti = i0 & 15; const bool isx2 = i0 >= 16;
#define PREP_LOAD(T_, D_) do { const bf16* row_ = QKV + (size_t)(T_) * INWP; const int tin_ = (T_) & (SEQ - 1); const int posA_ = blk ? (tin_ & 63) : (tin_ >> 6); \
        D_.wq = *(const u32x2*)(row_ + 4 * lane); \
        D_.wk = lane < 32 ? *(const u32x2*)(row_ + 256 + 4 * lane) : (u32x2){0u, 0u}; \
        D_.wcq = lane < 48 ? *(const u32x2*)(row_ + 1792 + 4 * lane) : (u32x2){0u, 0u}; \
        D_.wckv = lane < 32 ? *(const u32x2*)(row_ + 1984 + 4 * lane) : (u32x2){0u, 0u}; \
        D_.wkr = lane < 8 ? *(const u32x2*)(row_ + 2112 + 4 * lane) : (u32x2){0u, 0u}; \
        D_.cA = *(const f32x4*)(cosT + posA_ * 16 + ti); D_.sA = *(const f32x4*)(sinT + posA_ * 16 + ti); \
        D_.cD = *(const f32x4*)(cosT + tin_ * 16 + ti); D_.sD = *(const f32x4*)(sinT + tin_ * 16 + ti); } while (0)
    PTok cur; if (gw < T_TOK) PREP_LOAD(gw, cur);
    for (int t = gw; t < T_TOK; t += NGW) {
        bf16* row = QKV + (size_t)t * INWP;
        PTok nxt = cur; if (t + NGW < T_TOK) PREP_LOAD(t + NGW, nxt);
        const u32x2 wq = cur.wq, wk = cur.wk, wcq = cur.wcq, wckv = cur.wckv, wkr = cur.wkr; const f32x4 cA = cur.cA, sA = cur.sA, cD = cur.cD, sD = cur.sD;
#pragma unroll
        for (int pass = 0; pass < 2; ++pass) {
            const bool act = (pass == 0) || (lane < 32);
            bf16* ptr = row + pass * 256 + 4 * lane;
            const u32x2 w = pass == 0 ? wq : wk;
            float x[4] = {bflo(w.x), bfhi(w.x), bflo(w.y), bfhi(w.y)};
            float ss = (x[0] * x[0] + x[1] * x[1]) + (x[2] * x[2] + x[3] * x[3]);
            ss += __shfl_xor(ss, 1); ss += __shfl_xor(ss, 2); ss += __shfl_xor(ss, 4); ss += __shfl_xor(ss, 8);
            const float rstd = 1.0f / sqrtf(ss * (1.f / 64.f) + EPS);
            const f32x4 g4 = pass == 0 ? gq4 : gk4;
            float y[4], o[4];
#pragma unroll
            for (int e = 0; e < 4; ++e) y[e] = x[e] * rstd * g4[e];
#pragma unroll
            for (int e = 0; e < 4; ++e) { const float pr = __shfl_xor(y[e], 4); o[e] = isx2 ? (y[e] * cA[e] + pr * sA[e]) : (y[e] * cA[e] - pr * sA[e]); if (pass == 0) o[e] *= CA; }
            if (act) { u32x2 ow; ow.x = pk2(o[0], o[1]); ow.y = pk2(o[2], o[3]); *(u32x2*)ptr = ow; }
        }
        {
            float x[4] = {bflo(wcq.x), bfhi(wcq.x), bflo(wcq.y), bfhi(wcq.y)};
            const float ss = wave_sum((x[0] * x[0] + x[1] * x[1]) + (x[2] * x[2] + x[3] * x[3]));
            const float rstd = 1.0f / sqrtf(ss * (1.f / 192.f) + EPS);
            if (lane < 48) { u32x2 ow; ow.x = pk2(x[0] * rstd * gdq4[0], x[1] * rstd * gdq4[1]); ow.y = pk2(x[2] * rstd * gdq4[2], x[3] * rstd * gdq4[3]); *(u32x2*)(DA + (size_t)t * 384 + 4 * lane) = ow; }
        }
        {
            float x[4] = {bflo(wckv.x), bfhi(wckv.x), bflo(wckv.y), bfhi(wckv.y)};
            const float ss = wave_sum((x[0] * x[0] + x[1] * x[1]) + (x[2] * x[2] + x[3] * x[3]));
            const float rstd = 1.0f / sqrtf(ss * (1.f / 128.f) + EPS);
            u32x2 ow; ow.x = pk2(x[0] * rstd * gdkv4[0], x[1] * rstd * gdkv4[1]); ow.y = pk2(x[2] * rstd * gdkv4[2], x[3] * rstd * gdkv4[3]);
            if (lane >= 32) { ow.x = 0u; ow.y = 0u; }
            if (lane < 48) *(u32x2*)(DA + (size_t)t * 384 + 192 + 4 * lane) = ow;
        }
        {
            float x[4] = {bflo(wkr.x), bfhi(wkr.x), bflo(wkr.y), bfhi(wkr.y)};
            float o[4];
#pragma unroll
            for (int e = 0; e < 4; ++e) { const float pr = __shfl_xor(x[e], 4); o[e] = isx2 ? (x[e] * cD[e] + pr * sD[e]) : (x[e] * cD[e] - pr * sD[e]); }
            if (lane < 8) { u32x2 ow; ow.x = pk2(o[0], o[1]); ow.y = pk2(o[2], o[3]); *(u32x2*)(KR + (size_t)t * 32 + 4 * lane) = ow; }
        }
        cur = nxt;
    }
#undef PREP_LOAD
}

__device__ __forceinline__ void phase_attention(const Params& kp, LAS unsigned char* lds, int l, char* ldsg, int vcu, int G) {
    asm volatile("" : "+s"(vcu));
    unsigned char* const ws_ = PWS();
    const bf16* QKV = (const bf16*)(ws_ + WS_BIG + BIG_QKV); const bf16* DX = (const bf16*)(ws_ + WS_BIG + BIG_DX); const bf16* KR = (const bf16*)(ws_ + WS_BIG + BIG_KR);
    bf16* BR = (bf16*)(ws_ + WS_BR);
    const int upc = (512 + G - 1) / G, u0 = vcu * upc, u1 = (u0 + upc) < 512 ? (u0 + upc) : 512;
    const float L2E = 1.4426950408889634f;
    att::UnitP P;
    P.cosT = (const float*)(ws_ + WS_COS); P.sinT = (const float*)(ws_ + WS_SIN); P.slope2 = 0.f; P.sink2 = 0.f; P.cscale = 1.f; P.K2 = nullptr;
    bool nomaxA;
    { const int ln = threadIdx.x & 63; float gq = fabsf(PIN(5)[l * 64 + ln]), gk = fabsf(PIN(6)[l * 64 + ln]);
#pragma unroll
      for (int o_ = 1; o_ < 64; o_ <<= 1) { gq = fmaxf(gq, __shfl_xor(gq, o_)); gk = fmaxf(gk, __shfl_xor(gk, o_)); }
      const float bound2 = 8.f * gq * gk * L2E * 1.02f;
      nomaxA = __builtin_amdgcn_readfirstlane(bound2 <= 40.f ? 1 : 0) != 0; }
    if (AEN(0)) for (int u = u0; u < u1; ++u) { const int bh = u >> 6, qb = u & 63, b = bh >> 2, h = bh & 3; const size_t r0 = (size_t)b * SEQ;
        P.Q = QKV + (r0 + qb * 256) * INWP + h * 64; P.K = QKV + r0 * INWP + 256 + (h >> 1) * 64; P.V = QKV + r0 * INWP + 384 + (h >> 1) * 64; P.O = BR + (r0 + qb * 256) * 1024 + h * 64;
        P.ldq = INWP; P.ldk = INWP; P.ldv = INWP; P.ldo = 1024; P.t_lo = 0; P.nt = 256; P.q0 = qb * 256;
        if (nomaxA) att::attn_unit<0, true>(P, ldsg); else att::attn_unit<0, false>(P, ldsg); }
    if (AEN(1)) for (int u = u0; u < u1; ++u) { const int bh = u >> 6, qb = u & 63, b = bh >> 2, h = bh & 3; const size_t r0 = (size_t)b * SEQ;
        P.Q = DX + (r0 + qb * 256) * 1024 + h * 96; P.K = DX + r0 * 1024 + 384 + h * 128; P.V = DX + r0 * 1024 + 384 + h * 128 + 64; P.K2 = KR + r0 * 32; P.O = BR + (r0 + qb * 256) * 1024 + 768 + h * 64;
        P.ldq = 1024; P.ldk = 1024; P.ldv = 1024; P.ldo = 1024; P.t_lo = 0; P.nt = 256; P.q0 = qb * 256; P.cscale = 0.10206207261596575f * L2E;
        att::attn_unit<1>(P, ldsg); }
    if (AEN(3)) for (int u = u0; u < u1; ++u) { const int bh = u >> 6, qb = u & 63, b = bh >> 2, h = bh & 3; const size_t r0 = (size_t)b * SEQ;
        P.Q = QKV + (r0 + qb * 256) * INWP + 1280 + h * 64; P.K = QKV + r0 * INWP + 1536 + (h >> 1) * 64; P.V = QKV + r0 * INWP + 1664 + (h >> 1) * 64; P.O = BR + (r0 + qb * 256) * 1024 + 512 + h * 64;
        P.ldq = INWP; P.ldk = INWP; P.ldv = INWP; P.ldo = 1024; P.q0 = qb * 256;
        int lo = qb * 4 - 2, hi = qb * 4 + 6; lo = lo < 0 ? 0 : lo; hi = hi > 256 ? 256 : hi; P.t_lo = lo; P.nt = hi - lo;
        P.cscale = 0.125f * L2E; P.slope2 = __builtin_amdgcn_exp2f(-2.f * (float)(h + 1)) * L2E; P.sink2 = PIN(8)[l * 4 + h] * L2E;
        att::attn_unit<3>(P, ldsg); }
    if (AEN(2)) for (int u = u0; u < u1; ++u) { const int bh = u >> 6, qb = u & 63, b = bh >> 2, h = bh & 3; const size_t r0 = (size_t)b * SEQ;
        { float* tab = (float*)(ldsg + att::OFF_TAB); const float* src = PIN(7) + ((size_t)l * 4 + h) * 465;
          for (int i = threadIdx.x; i < 466; i += 512) tab[i] = i < 465 ? src[i] * L2E : -INFINITY;
          __syncthreads(); }
        P.Q = QKV + (r0 + qb * 256) * INWP + 512 + h * 64; P.K = QKV + r0 * INWP + 768 + h * 64; P.V = QKV + r0 * INWP + 1024 + h * 64; P.O = BR + (r0 + qb * 256) * 1024 + 256 + h * 64;
        P.ldq = INWP; P.ldk = INWP; P.ldv = INWP; P.ldo = 1024; P.q0 = qb * 256;
        const int ra = qb * 4, rb = qb * 4 + 3;
        int lo = ra - 4; lo = lo < 0 ? 0 : (lo > 248 ? 248 : lo);
        int hi = rb - 4; hi = hi < 0 ? 0 : (hi > 248 ? 248 : hi); hi += 8;
        if ((hi - lo) & 1) { if (hi < 256) ++hi; else --lo; }
        P.t_lo = lo; P.nt = hi - lo; P.cscale = 0.125f * L2E;
        att::attn_unit<2>(P, ldsg); }
}

template <int S_>
__device__ __forceinline__ void run_sub(const Params& kp, int l, LAS unsigned char* lds, unsigned char* lds_raw, int gw, int NGW, int lane, int vcu, int G, int bx) {
    constexpr int s = S_;
    unsigned char* ws = PWS();
    bf16* H = (bf16*)POUT();
    bf16* XR = (bf16*)(ws + WS_H);
    bf16* BR = (bf16*)(ws + WS_BR); bf16* BIG = (bf16*)(ws + WS_BIG);
    unsigned char* wb = ws + WS_W + (size_t)l * W_LAYER;
    pg8::StaticOrder S;
    if constexpr (s == 0) { if (EN(1)) { if (l == 0) phase_norm(PIN(0), PIN(1), H, gw, NGW, lane); else phase_norm_bf(XR, PIN(1) + l * DM, H, gw, NGW, lane); } }
    else if constexpr (s == 2) { if (EN(3)) phase_prep(kp, lds, l, gw, NGW, lane); }
    else if constexpr (s == 4) { if (EN(5)) { phase_attention(kp, lds, l, (char*)lds_raw, vcu, G); if (PROBE_DUP == 1 && l == 0) { __syncthreads(); phase_attention(kp, lds, l, (char*)lds_raw, vcu, G); } } }
    else if constexpr (s == 8) { if (EN(9)) phase_norm_bf(XR, PIN(15) + l * DM, H, gw, NGW, lane); }
    else if constexpr (s == 1 || s == 3 || s == 5) {
        if (EN(2)) {
        pg8::Gemm g; pg8::EpiBf16<0> E;
        if (s == 1) { g = pg8::Gemm{H, (const bf16*)(wb + WO_IN), T_TOK, INWP, DM, DM, DM, 30, 0}; E = pg8::EpiBf16<0>{BIG + BIG_QKV / 2, INWP}; }
        else if (s == 3) { g = pg8::Gemm{BIG + BIG_DA / 2, (const bf16*)(wb + WO_D), T_TOK, 1024, 384, 384, 384, 30, 0}; E = pg8::EpiBf16<0>{BIG + BIG_DX / 2, 1024}; }
        else { g = pg8::Gemm{BR, (const bf16*)(wb + WO_B), T_TOK, 4096, 256, 1024, 256, 2, 256}; E = pg8::EpiBf16<0>{BIG, 4096}; }
        S.init(T_TOK, g.N, G, bx);
        pg8::gemm_phase<pg8::EpiBf16<0>, true>(lds, g, S, E); } }
    else if constexpr (s == 6) {
        if (EN(7)) {
        pg8::Gemm g{H, (const bf16*)(wb + WO_G), T_TOK, 4096, DM, DM, DM, 30, 0}; S.init(T_TOK, 4096, G, bx);
        pg8::EpiMerge E{BIG, PIN(4) + (size_t)l * 4096, BR};
        pg8::gemm_phase<pg8::EpiMerge, true>(lds, g, S, E); } }
    else if constexpr (s == 9) {
        if (EN(10)) {
        pg8::Gemm g{H, (const bf16*)(wb + WO_1), T_TOK, FF, DM, DM, DM, 30, 0}; S.init(T_TOK, FF, G, bx);
        pg8::EpiBf16<1> E{BIG, FF};
        pg8::gemm_phase<pg8::EpiBf16<1>, true>(lds, g, S, E);
        if (PROBE_DUP == 2 && l == 0) pg8::gemm_phase<pg8::EpiBf16<1>, true>(lds, g, S, E); } }
    else {
        if (EN(8)) {
        pg8::Gemm g;
        if (s == 7) g = pg8::Gemm{BR, (const bf16*)(wb + WO_O), T_TOK, DM, DM, DM, DM, 30, 0};
        else g = pg8::Gemm{BIG, (const bf16*)(wb + WO_2), T_TOK, DM, FF, FF, FF, 30, 0};
        S.init(T_TOK, DM, G, bx);
        if (s == 7 && l == 0) { pg8::EpiRes<false> E{PIN(0), XR, DM}; pg8::gemm_phase<pg8::EpiRes<false>, true>(lds, g, S, E); }
        else { pg8::EpiRes<true> E{XR, XR, DM}; pg8::gemm_phase<pg8::EpiRes<true>, true>(lds, g, S, E); } } }
}

__global__ void __launch_bounds__(512, 2) fwd_megakernel(Params p) {
    extern __shared__ __attribute__((aligned(16))) unsigned char lds_raw[];
    cg::grid_group grid = cg::this_grid();
    LAS unsigned char* lds = (LAS unsigned char*)lds_raw;
    const int tid = threadIdx.x, lane = tid & 63, wave = __builtin_amdgcn_readfirstlane(tid >> 6);
    const int G = gridDim.x, bx = blockIdx.x;
    const int vcu = (G % 8 == 0) ? (bx % 8) * (G / 8) + bx / 8 : bx;
    const int gw = vcu * 8 + wave, NGW = G * 8;
    const int ph_lo = p.ph_lo, ph_hi = p.ph_hi;
    volatile LAS unsigned* MISC = (volatile LAS unsigned*)(lds + PAR_OFF);
    if (tid < 2) MISC[tid] = 0u;
    __syncthreads();
    const XcdBarrier xbar = xcd_barrier_post((unsigned*)p.ws, MISC);
#define RUN_PH(ph, ...) do { if (ph_lo <= (ph) && (ph) < ph_hi) { __VA_ARGS__; if ((ph) + 1 < ph_hi) { if ((ph) == 0) grid.sync(); else xcd_barrier(xbar); } } } while (0)
#define RUN_SUB(L, S_) RUN_PH(1 + (L) * 11 + (S_), run_sub<S_>(p, (L), lds, lds_raw, gw, NGW, lane, vcu, G, bx))
#define RUN_LAYER(L) do { RUN_SUB(L, 0); RUN_SUB(L, 1); RUN_SUB(L, 2); RUN_SUB(L, 3); RUN_SUB(L, 4); RUN_SUB(L, 5); RUN_SUB(L, 6); RUN_SUB(L, 7); RUN_SUB(L, 8); RUN_SUB(L, 9); RUN_SUB(L, 10); } while (0)
#define RUN_LAYER_REST(L) do { RUN_SUB(L, 1); RUN_SUB(L, 2); RUN_SUB(L, 3); RUN_SUB(L, 4); RUN_SUB(L, 5); RUN_SUB(L, 6); RUN_SUB(L, 7); RUN_SUB(L, 8); RUN_SUB(L, 9); RUN_SUB(L, 10); } while (0)
    RUN_PH(0, if (EN(0)) { phase_prologue(p, lds, gw, NGW, wave, lane); run_sub<0>(p, 0, lds, lds_raw, gw, NGW, lane, vcu, G, bx); });
    RUN_LAYER_REST(0);
    RUN_SUB(1, 0);
    RUN_LAYER_REST(1);
    RUN_PH(23, if (EN(12)) phase_final_norm((const bf16*)(p.ws + WS_H), p.in[18], p.out, gw, NGW, lane));
}

extern "C" void kernel_launch(void* const* d_in, const int* in_sizes, int n_in, void* d_out, int out_size, void* d_ws, size_t ws_size, hipStream_t stream) {
    static int grid = 0;
    if (grid == 0) {
        if (n_in != 19 || in_sizes[0] != T_TOK * DM || out_size != T_TOK * DM || ws_size < WS_END) {
            fprintf(stderr, "kernel_launch: unexpected shapes (n_in %d, in0 %d, out %d, ws %zu); nothing launched\n", n_in, n_in > 0 ? in_sizes[0] : -1, out_size, ws_size); grid = -1; return; }
        int dev = 0, cus = 0, per_cu = 0;
        if (hipGetDevice(&dev) != hipSuccess || hipDeviceGetAttribute(&cus, hipDeviceAttributeMultiprocessorCount, dev) != hipSuccess) { grid = -1; return; }
        if (hipFuncSetAttribute((const void*)fwd_megakernel, hipFuncAttributeMaxDynamicSharedMemorySize, LDS_TOTAL) != hipSuccess) { fprintf(stderr, "kernel_launch: hipFuncSetAttribute failed\n"); grid = -1; return; }
        if (hipOccupancyMaxActiveBlocksPerMultiprocessor(&per_cu, (const void*)fwd_megakernel, 512, LDS_TOTAL) != hipSuccess || per_cu < 1) { fprintf(stderr, "kernel_launch: occupancy query failed (%d)\n", per_cu); per_cu = 1; }
        (void)hipGetLastError();
        grid = cus * per_cu;
    }
    if (grid < 0) return;
    if (hipMemsetAsync(d_ws, 0, 16384, stream) != hipSuccess) { fprintf(stderr, "kernel_launch: memset of the barrier words failed\n"); return; }
    Params prm{};
    for (int i = 0; i < 19; ++i) prm.in[i] = (const float*)d_in[i];
    prm.out = (float*)d_out; prm.ws = (unsigned char*)d_ws;
#if MK_PER_PHASE
    for (int ph = 0; ph < 24; ++ph) { prm.ph_lo = ph; prm.ph_hi = ph + 1; void* args[] = {&prm};
        hipError_t e = hipLaunchCooperativeKernel((const void*)fwd_megakernel, dim3(grid), dim3(512), args, LDS_TOTAL, stream);
        if (e != hipSuccess) { fprintf(stderr, "cooperative launch failed: %s (grid %d)\n", hipGetErrorString(e), grid); break; } }
#else
    prm.ph_lo = 0; prm.ph_hi = 24; void* args[] = {&prm};
    hipError_t e = hipLaunchCooperativeKernel((const void*)fwd_megakernel, dim3(grid), dim3(512), args, LDS_TOTAL, stream);
    if (e != hipSuccess) fprintf(stderr, "cooperative launch failed: %s (grid %d)\n", hipGetErrorString(e), grid);
#endif
}
```
